# Optimizing an MI355X kernel written in HIP

```python
import jax, jax.numpy as jnp
from jax import lax
import numpy as np

D_MODEL = 1024
BATCH = 8
SEQ = 4096
DEPTH = 4

CHUNK = 64
N_MEM = 256
EPS = 1e-6
GLA_HEADS = 4
GLA_DK = 64
GLA_DV = 128
GLA_WIDTH = GLA_HEADS * GLA_DV
GLA_KW = GLA_HEADS * GLA_DK
GATE_RANK = 16
GATE_TAU = 16.0
SG_WIDTH = D_MODEL - GLA_WIDTH
SG_GROUPS = 4
SG_GROUP_CH = SG_WIDTH // SG_GROUPS
SG_BLOCK = 128
X_HEADS = 4
X_HEAD_DIM = D_MODEL // X_HEADS
D_FF = -(-8 * D_MODEL // (3 * 256)) * 256
OFF_Q = 0
OFF_K = OFF_Q + GLA_KW
OFF_V = OFF_K + GLA_KW
OFF_G = OFF_V + GLA_WIDTH
OFF_A = OFF_G + GLA_WIDTH
OFF_U = OFF_A + GATE_RANK
OFF_SV = OFF_U + SG_WIDTH
D_IN = OFF_SV + SG_WIDTH

kernel_name = "hybrid_gla_gmlp_memxattn_sandwich"


def rmsnorm(x, g):
    xf = x.astype(jnp.float32)
    y = xf * lax.rsqrt(jnp.mean(xf * xf, axis=-1, keepdims=True) + EPS)
    return (y * g.astype(jnp.float32)).astype(x.dtype)


def layernorm(x, g, b):
    xf = x.astype(jnp.float32)
    mu = jnp.mean(xf, axis=-1, keepdims=True)
    var = jnp.mean(jnp.square(xf - mu), axis=-1, keepdims=True)
    y = (xf - mu) * lax.rsqrt(var + EPS)
    return (y * g.astype(jnp.float32) + b.astype(jnp.float32)).astype(x.dtype)


def gla_mixer(q, k, v, g, a_lr, w_gate_up, b_gate, onorm):
    B, S, _ = q.shape
    nc = S // CHUNK
    qc = q.reshape(B, nc, CHUNK, GLA_HEADS, GLA_DK).astype(jnp.float32) * (GLA_DK ** -0.5)
    kc = k.reshape(B, nc, CHUNK, GLA_HEADS, GLA_DK).astype(jnp.float32)
    vc = v.reshape(B, nc, CHUNK, GLA_HEADS, GLA_DV).astype(jnp.float32)
    loga = jax.nn.log_sigmoid((a_lr @ w_gate_up + b_gate).astype(jnp.float32)) / GATE_TAU
    loga = loga.reshape(B, nc, CHUNK, GLA_HEADS, GLA_DK)
    cum = jnp.cumsum(loga, axis=2)
    cum_end = cum[:, :, -1:]
    k_dec = kc * jnp.exp(cum_end - cum)
    u_c = jnp.einsum('bnchk,bnchv->nbhkv', k_dec, vc)
    a_c = jnp.moveaxis(jnp.exp(cum_end[:, :, 0]), 1, 0)

    def step(state, inp):
        a, u = inp
        state = a[..., None] * state + u
        return state, state

    s0 = jnp.zeros((B, GLA_HEADS, GLA_DK, GLA_DV), jnp.float32)
    _, states = lax.scan(step, s0, (a_c, u_c))
    o = jnp.einsum('bnchk,nbhkv->bnchv', qc, states).reshape(B, S, GLA_HEADS, GLA_DV)
    o = o * lax.rsqrt(jnp.mean(o * o, axis=-1, keepdims=True) + EPS)
    o = o.reshape(B, S, GLA_WIDTH) * onorm.astype(jnp.float32)
    return (o * jax.nn.silu(g.astype(jnp.float32))).astype(q.dtype)


def spatial_gating_mixer(u, sv, ln_g, ln_b, w_s, b_s):
    B, S, _ = u.shape
    nb = S // SG_BLOCK
    u = jax.nn.gelu(u)
    sv = layernorm(jax.nn.gelu(sv), ln_g, ln_b)
    pos = jnp.arange(SG_BLOCK) // CHUNK
    mask = (pos[None, :] <= pos[:, None]).astype(w_s.dtype)
    svb = sv.reshape(B, nb, SG_BLOCK, SG_GROUPS, SG_GROUP_CH)
    z = jnp.einsum('gij,bnjgc->bnigc', w_s * mask, svb) + b_s.T[None, None, :, :, None]
    return u * z.reshape(B, S, SG_WIDTH)


def memory_cross_attention(xn, memn, w_xq, w_xkv, w_xo):
    B, S, _ = xn.shape
    q = (xn @ w_xq).reshape(B, S, X_HEADS, X_HEAD_DIM)
    kv = memn @ w_xkv
    k = kv[..., :D_MODEL].reshape(B, N_MEM, X_HEADS, X_HEAD_DIM)
    v = kv[..., D_MODEL:].reshape(B, N_MEM, X_HEADS, X_HEAD_DIM)
    s = jnp.einsum('bshd,bmhd->bhsm', q, k).astype(jnp.float32) * (X_HEAD_DIM ** -0.5)
    p = jax.nn.softmax(s, axis=-1).astype(v.dtype)
    o = jnp.einsum('bhsm,bmhd->bshd', p, v).reshape(B, S, D_MODEL)
    return o @ w_xo


def swiglu_ffn(xn, w_gu, w_down):
    h = xn @ w_gu
    return (jax.nn.silu(h[..., :D_FF]) * h[..., D_FF:]) @ w_down


def setup_inputs(seed: int = 0) -> dict:
    key = jax.random.key(seed)
    ks = jax.random.split(key, 24)
    L = DEPTH

    def w(k, shape, fan_in):
        return jax.random.normal(k, shape, jnp.float32) * (fan_in ** -0.5)

    def gain(k, shape):
        return 1.0 + 0.02 * jax.random.normal(k, shape, jnp.float32)

    def small(k, shape):
        return 0.02 * jax.random.normal(k, shape, jnp.float32)

    return {
        "x": jax.random.normal(ks[0], (BATCH, SEQ, D_MODEL), jnp.float32),
        "mem": jax.random.normal(ks[1], (BATCH, N_MEM, D_MODEL), jnp.float32),
        "norm_mix_pre": gain(ks[2], (L, D_MODEL)),
        "w_in": w(ks[3], (L, D_MODEL, D_IN), D_MODEL),
        "w_gate_up": w(ks[4], (L, GATE_RANK, GLA_KW), GATE_RANK),
        "b_gate": 0.5 + 0.1 * jax.random.normal(ks[5], (L, GLA_KW), jnp.float32),
        "gla_onorm": gain(ks[6], (L, GLA_WIDTH)),
        "sg_ln_g": gain(ks[7], (L, SG_WIDTH)),
        "sg_ln_b": small(ks[8], (L, SG_WIDTH)),
        "w_spatial": 0.5 * w(ks[9], (L, SG_GROUPS, SG_BLOCK, SG_BLOCK), SG_BLOCK),
        "b_spatial": gain(ks[10], (L, SG_GROUPS, SG_BLOCK)),
        "w_out": w(ks[11], (L, GLA_WIDTH + SG_WIDTH, D_MODEL), GLA_WIDTH + SG_WIDTH),
        "norm_mix_post": gain(ks[12], (L, D_MODEL)),
        "norm_x_pre": gain(ks[13], (L, D_MODEL)),
        "norm_mem": gain(ks[14], (L, D_MODEL)),
        "w_xq": w(ks[15], (L, D_MODEL, D_MODEL), D_MODEL),
        "w_xkv": w(ks[16], (L, D_MODEL, 2 * D_MODEL), D_MODEL),
        "w_xo": w(ks[17], (L, D_MODEL, D_MODEL), D_MODEL),
        "norm_x_post": gain(ks[18], (L, D_MODEL)),
        "norm_ffn_pre": gain(ks[19], (L, D_MODEL)),
        "w_ffn_gu": w(ks[20], (L, D_MODEL, 2 * D_FF), D_MODEL),
        "w_ffn_down": w(ks[21], (L, D_FF, D_MODEL), D_FF),
        "norm_ffn_post": gain(ks[22], (L, D_MODEL)),
    }


def reference(x, mem, norm_mix_pre, w_in, w_gate_up, b_gate, gla_onorm, sg_ln_g, sg_ln_b,
              w_spatial, b_spatial, w_out, norm_mix_post, norm_x_pre, norm_mem, w_xq, w_xkv,
              w_xo, norm_x_post, norm_ffn_pre, w_ffn_gu, w_ffn_down, norm_ffn_post):
    for l in range(DEPTH):
        xn = rmsnorm(x, norm_mix_pre[l])
        h = xn @ w_in[l]
        gla_out = gla_mixer(h[..., OFF_Q:OFF_K], h[..., OFF_K:OFF_V], h[..., OFF_V:OFF_G],
                            h[..., OFF_G:OFF_A], h[..., OFF_A:OFF_U],
                            w_gate_up[l], b_gate[l], gla_onorm[l])
        sg_out = spatial_gating_mixer(h[..., OFF_U:OFF_SV], h[..., OFF_SV:D_IN],
                                      sg_ln_g[l], sg_ln_b[l], w_spatial[l], b_spatial[l])
        mix = jnp.concatenate([gla_out, sg_out], axis=-1) @ w_out[l]
        x = x + rmsnorm(mix, norm_mix_post[l])
        xa = memory_cross_attention(rmsnorm(x, norm_x_pre[l]), rmsnorm(mem, norm_mem[l]),
                                    w_xq[l], w_xkv[l], w_xo[l])
        x = x + rmsnorm(xa, norm_x_post[l])
        f = swiglu_ffn(rmsnorm(x, norm_ffn_pre[l]), w_ffn_gu[l], w_ffn_down[l])
        x = x + rmsnorm(f, norm_ffn_post[l])
    return x
```

```cpp
#include <hip/hip_runtime.h>
#include <hip/hip_cooperative_groups.h>
#include <cstdio>
namespace cg = cooperative_groups;

#define LAS __attribute__((address_space(3)))
typedef unsigned short bf16_t;
typedef short bf16x8 __attribute__((ext_vector_type(8)));
typedef float f32x4 __attribute__((ext_vector_type(4)));
typedef unsigned u32x4 __attribute__((ext_vector_type(4)));
typedef unsigned u32x2 __attribute__((ext_vector_type(2)));

constexpr int BATCH = 8, SEQ = 4096, DM = 1024, MTOK = BATCH * SEQ, NMEM = 256, DEPTH = 4;
constexpr int DIN = 2576, DINP = 2816, DFF = 2816;
constexpr int OFF_Q = 0, OFF_K = 256, OFF_V = 512, OFF_G = 1024, OFF_A = 1536, OFF_U = 1552, OFF_SV = 2064;
constexpr float EPS = 1e-6f;
constexpr int PROBE = 0;

constexpr size_t WIN_O = 0, WOUT_O = 2883584, WXQ_O = 3932160, WXKV_O = 4980736, WXO_O = 7077888, WGU_O = 8126464, WDN_O = 13893632, WL_SZ = 16777216;
constexpr size_t MiB = 1048576;
constexpr size_t WS_W = 0, WS_K = 128 * MiB, WS_VT = 144 * MiB, WS_XN = 160 * MiB, WS_H = 224 * MiB, WS_Y = 400 * MiB, WS_AC = 464 * MiB, WS_BAR = 465 * MiB, WS_MEMN = 466 * MiB, WS_END = 482 * MiB;

constexpr int LDS_MAIN = 139264, LDS_BYTES = LDS_MAIN + 16;

struct Params {
    const float* in[23];
    float* out;
    unsigned char* ws;
};
typedef const __attribute__((address_space(4))) Params* KP;
__device__ __forceinline__ KP fresh(KP k) { asm volatile("" : "+s"(k)); return k; }

typedef __bf16 bf16v2 __attribute__((ext_vector_type(2)));
typedef float f32v2 __attribute__((ext_vector_type(2)));
__device__ __forceinline__ unsigned cvt_pk_bf16(float lo, float hi) { const f32v2 f = {lo, hi}; return __builtin_bit_cast(unsigned, __builtin_convertvector(f, bf16v2)); }
__device__ __forceinline__ int otid(int wv) { int t; asm volatile("v_mbcnt_lo_u32_b32 %0, -1, 0\n\tv_mbcnt_hi_u32_b32 %0, -1, %0\n\tv_lshl_add_u32 %0, %1, 6, %0" : "=&v"(t) : "s"(wv)); return t; }
__device__ __forceinline__ float bf_lo(unsigned w) { return __uint_as_float(w << 16); }
__device__ __forceinline__ float bf_hi(unsigned w) { return __uint_as_float(w & 0xffff0000u); }
__device__ __forceinline__ float bf2f(bf16_t b) { return __uint_as_float(((unsigned)b) << 16); }
__device__ __forceinline__ float shx(float v, int m, int lane) { return __int_as_float(__builtin_amdgcn_ds_bpermute((lane ^ m) << 2, __float_as_int(v))); }
__device__ __forceinline__ float wave_sum(float v, int lane) {
#pragma unroll
    for (int o = 32; o > 0; o >>= 1) v += shx(v, o, lane);
    return v;
}
__device__ __forceinline__ float gelu_tanh(float x) {
    const float y2 = 1.5957691216057308f * (x + 0.044715f * x * x * x);
    return x * __builtin_amdgcn_rcpf(1.0f + __expf(-y2));
}
__device__ __forceinline__ float silu_f(float x) { return x * __builtin_amdgcn_rcpf(1.0f + __expf(-x)); }
__device__ __forceinline__ float logsigmoid_f(float z) { return fminf(z, 0.0f) - __logf(1.0f + __expf(-fabsf(z))); }

namespace pg8 {
constexpr int BM = 256, BK = 64, HALF = 128, HTB = HALF * BK * 2, STAGE_BYTES = 8 * HTB, NXCD = 8, WGM = 8;
__device__ __forceinline__ int lds_byte(int r, int c) { const int st = (r >> 4) * 2 + (c >> 5), rr = r & 15, cc = c & 31, ob = rr * 64 + cc * 2; return st * 1024 + (ob ^ (((ob >> 9) & 1) << 5)); }
__device__ __forceinline__ void stage_rc(int b, int& R, int& C) { const int st = b / 1024, sb = b % 1024, swz = sb ^ (((sb >> 9) & 1) << 5); R = (st >> 1) * 16 + swz / 64; C = (st & 1) * 32 + (swz % 64) / 2; }
__device__ __forceinline__ int perm32(int rho) { const int n = rho >> 4, i = rho & 15; return 8 * (i >> 2) + 4 * n + (i & 3); }

struct Unit { const char* a; const char* b; size_t o; int ldc; int row0; };

__device__ __forceinline__ bool std_tile(int i, int G, int c, int nM, int nN, int& pm, int& pn) {
    const int nwg = nM * nN; const long L = (long)i * G + c; if (L >= nwg) return false;
    int wgid = (int)L; { const int q = nwg / NXCD, r = nwg % NXCD, xcd = wgid % NXCD, off = wgid / NXCD; wgid = (xcd < r ? xcd * (q + 1) : r * (q + 1) + (xcd - r) * q) + off; }
    const int nig = WGM * nN, gid = wgid / nig, fm = gid * WGM, gsz = (nM - fm) < WGM ? (nM - fm) : WGM;
    pm = fm + ((wgid % nig) % gsz); pn = (wgid % nig) / gsz; return true;
}
template <int MODE> struct SchedStd {
    const bf16_t* A; const bf16_t* Bt; int nM, nN, lda, ldb, ldc, G, c;
    __device__ __forceinline__ bool next(int i, Unit& u) const {
        int pm, pn; if (!std_tile(i, G, c, nM, nN, pm, pn)) return false;
        u.a = (const char*)(A + (size_t)pm * 256 * lda); u.b = (const char*)(Bt + (size_t)pn * 256 * ldb);
        u.o = (size_t)pm * 256 * ldc + (size_t)pn * (MODE == 1 ? 128 : 256); u.ldc = ldc; u.row0 = pm * 256; return true;
    }
};
struct SchedInKV {
    const bf16_t* A; const bf16_t* Bt; const bf16_t* memn; const bf16_t* Wkv; int l, G, c;
    __device__ __forceinline__ bool next(int i, Unit& u) const {
        int pm, pn;
        if (std_tile(i, G, c, 128, 11, pm, pn)) { u.a = (const char*)(A + (size_t)pm * 256 * 1024); u.b = (const char*)(Bt + (size_t)pn * 256 * 1024);
            u.o = WS_H / 2 + (size_t)pm * 256 * DINP + (size_t)pn * 256; u.ldc = DINP; u.row0 = pm * 256; return true; }
        const long r = (long)i * G + c - 1408; if (r >= 64) return false;
        u.row0 = -1;
        if (r < 32) { const int b = (int)r >> 2, pn2 = (int)r & 3; u.a = (const char*)(memn + (size_t)b * 256 * 1024); u.b = (const char*)(Wkv + (size_t)pn2 * 256 * 1024);
            u.o = WS_K / 2 + ((size_t)l * 2048 + b * 256) * 1024 + pn2 * 256; u.ldc = 1024; }
        else { const int rr = (int)r - 32, pm2 = rr >> 3, b = rr & 7; u.a = (const char*)(Wkv + (size_t)(1024 + pm2 * 256) * 1024); u.b = (const char*)(memn + (size_t)b * 256 * 1024);
            u.o = WS_VT / 2 + (((size_t)l * 8 + b) * 1024 + pm2 * 256) * 256; u.ldc = 256; }
        return true;
    }
};
struct SchedKV {
    const bf16_t* memn; const bf16_t* W; size_t kbase, vbase; int G, c;
    __device__ __forceinline__ bool next(int i, Unit& u) const {
        const long L = (long)i * G + c; if (L >= 256) return false;
        const int l = (int)L >> 6, r = (int)L & 63; const bf16_t* wl = W + (size_t)l * WL_SZ + WXKV_O; const bf16_t* ml = memn + (size_t)l * 2048 * 1024;
        if (r < 32) { const int b = r >> 2, pn = r & 3; u.a = (const char*)(ml + (size_t)b * 256 * 1024); u.b = (const char*)(wl + (size_t)pn * 256 * 1024);
            u.o = kbase + ((size_t)l * 2048 + b * 256) * 1024 + pn * 256; u.ldc = 1024; u.row0 = 0; }
        else { const int rr = r - 32, pm = rr >> 3, b = rr & 7; u.a = (const char*)(wl + (size_t)(1024 + pm * 256) * 1024); u.b = (const char*)(ml + (size_t)b * 256 * 1024);
            u.o = vbase + (((size_t)l * 8 + b) * 1024 + pm * 256) * 256; u.ldc = 256; u.row0 = 0; }
        return true;
    }
};
template <int MODE> struct SchedAttn {
    const bf16_t* A; const bf16_t* Bm; int G, c;
    __device__ __forceinline__ bool next(int i, Unit& u) const {
        const long L = (long)i * G + c; if (L >= 512) return false;
        int pm = (int)L >> 2, h = (int)L & 3;
        if (G == 256) { pm = i * 64 + (c & 7) * 8 + (c >> 5); h = (c >> 3) & 3; }
        const int b = pm >> 4;
        u.a = (const char*)(A + (size_t)pm * 256 * 1024 + (MODE == 2 ? 0 : h * 256));
        u.b = MODE == 0 ? (const char*)(Bm + (size_t)b * 256 * 1024 + h * 256) : (MODE == 1 ? (const char*)(Bm + ((size_t)b * 1024 + h * 256) * 256) : (const char*)(Bm + (size_t)h * 256 * 1024));
        u.o = (size_t)pm * 256 * 1024 + h * 256; u.ldc = 1024; u.row0 = pm * 256; return true;
    }
};

struct EpiBf16 {
    static constexpr bool PERM = true; bf16_t* O; const float* rs = nullptr;
    __device__ __forceinline__ void operator()(const f32x4 (&acc)[2][2][4][2], const Unit& u, int wr, int wc, int fr, int fq) const {
        bf16_t* base = O + u.o + (size_t)(wr * 64 + fr) * u.ldc + wc * 32 + 8 * fq;
#pragma unroll
        for (int ai = 0; ai < 2; ++ai)
#pragma unroll
            for (int m = 0; m < 4; ++m) { bf16_t* rowp = base + (size_t)(ai * HALF + m * 16) * u.ldc; const float sc = (rs && u.row0 >= 0) ? rs[u.row0 + ai * HALF + wr * 64 + m * 16 + fr] : 1.0f;
#pragma unroll
                for (int bj = 0; bj < 2; ++bj) { const f32x4 v0 = acc[ai][bj][m][0] * sc, v1 = acc[ai][bj][m][1] * sc;
                    u32x4 w; w.x = cvt_pk_bf16(v0[0], v0[1]); w.y = cvt_pk_bf16(v0[2], v0[3]); w.z = cvt_pk_bf16(v1[0], v1[1]); w.w = cvt_pk_bf16(v1[2], v1[3]);
                    *(u32x4*)(rowp + bj * HALF) = w; } }
    }
};
struct EpiSwiglu {
    static constexpr bool PERM = true; bf16_t* O; const float* rs;
    __device__ __forceinline__ void operator()(const f32x4 (&acc)[2][2][4][2], const Unit& u, int wr, int wc, int fr, int fq) const {
        bf16_t* base = O + u.o + (size_t)(wr * 64 + fr) * u.ldc + wc * 32 + 8 * fq;
#pragma unroll
        for (int ai = 0; ai < 2; ++ai)
#pragma unroll
            for (int m = 0; m < 4; ++m) { bf16_t* rowp = base + (size_t)(ai * HALF + m * 16) * u.ldc; const float sc = rs[u.row0 + ai * HALF + wr * 64 + m * 16 + fr];
                float r[8];
#pragma unroll
                for (int n = 0; n < 2; ++n)
#pragma unroll
                    for (int e = 0; e < 4; ++e) r[n * 4 + e] = silu_f(acc[ai][0][m][n][e] * sc) * (acc[ai][1][m][n][e] * sc);
                u32x4 w; w.x = cvt_pk_bf16(r[0], r[1]); w.y = cvt_pk_bf16(r[2], r[3]); w.z = cvt_pk_bf16(r[4], r[5]); w.w = cvt_pk_bf16(r[6], r[7]);
                *(u32x4*)rowp = w; }
    }
};
struct EpiSoftmax {
    static constexpr bool PERM = true; bf16_t* O; float scale2; LAS float* st;
    __device__ __forceinline__ void operator()(f32x4 (&acc)[2][2][4][2], const Unit& u, int wr, int wc, int fr, int fq) const {
#pragma unroll
        for (int ai = 0; ai < 2; ++ai)
#pragma unroll
            for (int m = 0; m < 4; ++m) { float mx = -3.0e38f;
#pragma unroll
                for (int bj = 0; bj < 2; ++bj)
#pragma unroll
                    for (int n = 0; n < 2; ++n)
#pragma unroll
                        for (int e = 0; e < 4; ++e) mx = fmaxf(mx, acc[ai][bj][m][n][e]);
                mx = fmaxf(mx, shx(mx, 16, fq * 16 + fr)); mx = fmaxf(mx, shx(mx, 32, fq * 16 + fr));
                if (fq == 0) st[(ai * HALF + wr * 64 + m * 16 + fr) * 4 + wc] = mx; }
        asm volatile("s_waitcnt lgkmcnt(0)" ::: "memory"); __builtin_amdgcn_s_barrier(); asm volatile("" ::: "memory");
#pragma unroll
        for (int ai = 0; ai < 2; ++ai)
#pragma unroll
            for (int m = 0; m < 4; ++m) { const int row = ai * HALF + wr * 64 + m * 16 + fr; const f32x4 m4 = *(const LAS f32x4*)(st + row * 4);
                const float mx = fmaxf(fmaxf(m4[0], m4[1]), fmaxf(m4[2], m4[3])); float sm = 0.f;
#pragma unroll
                for (int bj = 0; bj < 2; ++bj)
#pragma unroll
                    for (int n = 0; n < 2; ++n)
#pragma unroll
                        for (int e = 0; e < 4; ++e) { const float ex = __builtin_amdgcn_exp2f((acc[ai][bj][m][n][e] - mx) * scale2); acc[ai][bj][m][n][e] = ex; sm += ex; }
                sm += shx(sm, 16, fq * 16 + fr); sm += shx(sm, 32, fq * 16 + fr);
                if (fq == 0) st[1024 + row * 4 + wc] = sm; }
        asm volatile("s_waitcnt lgkmcnt(0)" ::: "memory"); __builtin_amdgcn_s_barrier(); asm volatile("" ::: "memory");
        bf16_t* base = O + u.o + (size_t)(wr * 64 + fr) * u.ldc + wc * 32 + 8 * fq;
#pragma unroll
        for (int ai = 0; ai < 2; ++ai)
#pragma unroll
            for (int m = 0; m < 4; ++m) { const int row = ai * HALF + wr * 64 + m * 16 + fr; const f32x4 s4 = *(const LAS f32x4*)(st + 1024 + row * 4);
                const float inv = 1.0f / ((s4[0] + s4[1]) + (s4[2] + s4[3])); bf16_t* rowp = base + (size_t)(ai * HALF + m * 16) * u.ldc;
#pragma unroll
                for (int bj = 0; bj < 2; ++bj) { const f32x4 v0 = acc[ai][bj][m][0] * inv, v1 = acc[ai][bj][m][1] * inv;
                    u32x4 w; w.x = cvt_pk_bf16(v0[0], v0[1]); w.y = cvt_pk_bf16(v0[2], v0[3]); w.z = cvt_pk_bf16(v1[0], v1[1]); w.w = cvt_pk_bf16(v1[2], v1[3]);
                    *(u32x4*)(rowp + bj * HALF) = w; } }
    }
};
struct EpiF32Scale {
    static constexpr bool PERM = false; float* O; float scale;
    __device__ __forceinline__ void operator()(const f32x4 (&acc)[2][2][4][2], const Unit& u, int wr, int wc, int fr, int fq) const {
        float* base = O + u.o + (size_t)(wr * 64 + fr) * u.ldc + wc * 32 + 4 * fq;
#pragma unroll
        for (int ai = 0; ai < 2; ++ai)
#pragma unroll
            for (int m = 0; m < 4; ++m) { float* rowp = base + (size_t)(ai * HALF + m * 16) * u.ldc;
#pragma unroll
                for (int bj = 0; bj < 2; ++bj)
#pragma unroll
                    for (int n = 0; n < 2; ++n) *(f32x4*)(rowp + bj * HALF + n * 16) = acc[ai][bj][m][n] * scale; }
    }
};

template <int lda, int ldb, int K, class Epi, class Sched>
__device__ __forceinline__ void gemm_phase(LAS unsigned char* lds, const Sched& S, const Epi& E, const int wv) {
    const int tid = otid(wv), wid = __builtin_amdgcn_readfirstlane(tid >> 6), lane = tid & 63, wr = wid >> 2, wc = wid & 3, fr = lane & 15, fq = lane >> 4;
    const int nt = K / BK;
    unsigned voffA[2], voffB[2];
#pragma unroll
    for (int i = 0; i < 2; ++i) { int R, C; stage_rc(tid * 16 + i * 8192, R, C); const int Rb = Epi::PERM ? ((R & ~31) + perm32(R & 31)) : R;
        voffA[i] = (unsigned)(R * lda + C) * 2u; voffB[i] = (unsigned)(Rb * ldb + C) * 2u; }
    const size_t kstep = (size_t)(BK * 2);
    const size_t hstepA = (size_t)HALF * lda * 2, hstepB = (size_t)HALF * ldb * 2;
    const unsigned ldsw = (unsigned)wid * 1024u;
    const int aoff = lds_byte(wr * 64 + fr, fq * 8), boff = lds_byte(wc * 32 + fr, fq * 8);
#define PG8_SA(b, h) (((b) * 2 + (h)) * HTB)
#define PG8_SB(b, h) ((4 + (b) * 2 + (h)) * HTB)
#define PG8_STAGE(bufoff, gbase, voff) do { _Pragma("unroll") for (int _i = 0; _i < 2; ++_i) \
        __builtin_amdgcn_global_load_lds((const unsigned*)((const char*)(gbase) + (voff)[_i]), (LAS unsigned*)(lds + (bufoff) + ldsw + _i * 8192), 16, 0, 0); } while (0)
#define PG8_LDA(dst, b, h) do { _Pragma("unroll") for (int m = 0; m < 4; ++m) _Pragma("unroll") for (int k = 0; k < 2; ++k) dst[m][k] = *(const LAS bf16x8*)(lds + PG8_SA(b, h) + aoff + m * 2048 + k * 1024); } while (0)
#define PG8_LDB(dst, b, h) do { _Pragma("unroll") for (int n = 0; n < 2; ++n) _Pragma("unroll") for (int k = 0; k < 2; ++k) dst[n][k] = *(const LAS bf16x8*)(lds + PG8_SB(b, h) + boff + n * 2048 + k * 1024); } while (0)
#define PG8_MMA(ai, bj, At, Bt) do { __builtin_amdgcn_s_setprio(1); _Pragma("unroll") for (int m = 0; m < 4; ++m) _Pragma("unroll") for (int n = 0; n < 2; ++n) _Pragma("unroll") for (int k = 0; k < 2; ++k) \
        acc[ai][bj][m][n] = __builtin_amdgcn_mfma_f32_16x16x32_bf16(Bt[n][k], At[m][k], acc[ai][bj][m][n], 0, 0, 0); __builtin_amdgcn_s_setprio(0); } while (0)
#define PG8_WAIT_V(n) asm volatile("s_waitcnt vmcnt(" #n ")" ::: "memory")
#define PG8_WAIT_L(n) asm volatile("s_waitcnt lgkmcnt(" #n ")" ::: "memory")
#define PG8_BAR __builtin_amdgcn_s_barrier()
#define PG8_SCHED __builtin_amdgcn_sched_barrier(0)
    Unit cur, nxt; int ui = 0;
    if (!S.next(0, cur)) return;
    const char* cA = cur.a; const char* cB = cur.b;
    f32x4 acc[2][2][4][2];
#pragma unroll
    for (int a = 0; a < 2; ++a)
#pragma unroll
        for (int b = 0; b < 2; ++b)
#pragma unroll
            for (int m = 0; m < 4; ++m)
#pragma unroll
                for (int n = 0; n < 2; ++n) acc[a][b][m][n] = (f32x4){0.f, 0.f, 0.f, 0.f};
    bf16x8 At[4][2], B0[2][2], B1[2][2];
    PG8_STAGE(PG8_SB(0, 0), cB, voffB); PG8_STAGE(PG8_SB(0, 1), cB + hstepB, voffB); PG8_STAGE(PG8_SA(0, 0), cA, voffA); PG8_STAGE(PG8_SA(0, 1), cA + hstepA, voffA);
    if (wr == 1) PG8_BAR;
    PG8_WAIT_V(2); PG8_BAR;
    PG8_STAGE(PG8_SB(1, 0), cB + kstep, voffB); PG8_STAGE(PG8_SA(1, 0), cA + kstep, voffA); PG8_STAGE(PG8_SB(1, 1), cB + hstepB + kstep, voffB);
    PG8_WAIT_V(6); PG8_BAR;
    for (;;) {
        const bool has_next = S.next(ui + 1, nxt);
        const char* nA = has_next ? nxt.a : cA; const char* nB = has_next ? nxt.b : cB;
#pragma unroll 1
        for (int t = 0; t < nt; t += 2) {
            const bool last = (t == nt - 2);
            const char* a1 = cA + (size_t)(t + 1) * kstep;
            const char* a2 = last ? nA : cA + (size_t)(t + 2) * kstep; const char* b2 = last ? nB : cB + (size_t)(t + 2) * kstep;
            const char* a3 = a2 + kstep; const char* b3 = b2 + kstep;
            PG8_LDB(B0, 0, 0); PG8_LDB(B1, 0, 1); PG8_SCHED; PG8_LDA(At, 0, 0); PG8_STAGE(PG8_SA(1, 1), a1 + hstepA, voffA);
            PG8_WAIT_V(8); PG8_WAIT_L(0); PG8_BAR; PG8_MMA(0, 0, At, B0); PG8_MMA(0, 1, At, B1); PG8_BAR; PG8_SCHED;
            PG8_LDA(At, 0, 1); PG8_STAGE(PG8_SB(0, 0), b2, voffB); PG8_STAGE(PG8_SB(0, 1), b2 + hstepB, voffB); PG8_STAGE(PG8_SA(0, 0), a2, voffA);
            PG8_WAIT_V(8); PG8_WAIT_L(0); PG8_BAR; PG8_MMA(1, 0, At, B0); PG8_MMA(1, 1, At, B1); PG8_BAR; PG8_SCHED;
            PG8_LDB(B0, 1, 0); PG8_LDB(B1, 1, 1); PG8_SCHED; PG8_LDA(At, 1, 0); PG8_STAGE(PG8_SA(0, 1), a2 + hstepA, voffA);
            PG8_WAIT_V(8); PG8_WAIT_L(0); PG8_BAR; PG8_MMA(0, 0, At, B0); PG8_MMA(0, 1, At, B1); PG8_BAR; PG8_SCHED;
            PG8_LDA(At, 1, 1); PG8_STAGE(PG8_SB(1, 0), b3, voffB); PG8_STAGE(PG8_SB(1, 1), b3 + hstepB, voffB); PG8_STAGE(PG8_SA(1, 0), a3, voffA);
            PG8_WAIT_V(8); PG8_WAIT_L(0); PG8_BAR; PG8_MMA(1, 0, At, B0); PG8_MMA(1, 1, At, B1); PG8_BAR; PG8_SCHED;
        }
        if (wr == 0) PG8_BAR;
        { const int l2 = otid(wv) & 63; E(acc, cur, wr, wc, l2 & 15, l2 >> 4); }
        if (!has_next) break;
#pragma unroll
        for (int a = 0; a < 2; ++a)
#pragma unroll
            for (int b = 0; b < 2; ++b)
#pragma unroll
                for (int m = 0; m < 4; ++m)
#pragma unroll
                    for (int n = 0; n < 2; ++n) acc[a][b][m][n] = (f32x4){0.f, 0.f, 0.f, 0.f};
        cur = nxt; cA = nA; cB = nB; ++ui;
        if (wr == 1) PG8_BAR;
    }
    PG8_WAIT_V(0);
    PG8_BAR;
#undef PG8_SA
#undef PG8_SB
#undef PG8_STAGE
#undef PG8_LDA
#undef PG8_LDB
#undef PG8_MMA
#undef PG8_WAIT_V
#undef PG8_WAIT_L
#undef PG8_BAR
#undef PG8_SCHED
}
}

struct ConvUnit { const float* src; bf16_t* dst; int Nsrc, k0, n0, ldd, drow0; const float* gk; };
__device__ __forceinline__ ConvUnit conv_decode(KP p, int t) {
    bf16_t* W = (bf16_t*)(p->ws + WS_W); const int l = t >> 10, r = t & 1023; bf16_t* wl = W + (size_t)l * WL_SZ; ConvUnit u;
    if (r < 176) { const int tn = r >> 2, kg = r & 3; u = ConvUnit{p->in[3] + (size_t)l * 1024 * DIN, wl + WIN_O, DIN, kg * 256, tn * 64, 1024, tn * 64, p->in[2] + (size_t)l * 1024}; }
    else if (r < 240) { const int q = r - 176, tn = q >> 2, kg = q & 3; u = ConvUnit{p->in[11] + (size_t)l * 1024 * 1024, wl + WOUT_O, 1024, kg * 256, tn * 64, 1024, tn * 64, nullptr}; }
    else if (r < 304) { const int q = r - 240, tn = q >> 2, kg = q & 3; u = ConvUnit{p->in[15] + (size_t)l * 1024 * 1024, wl + WXQ_O, 1024, kg * 256, tn * 64, 1024, tn * 64, p->in[13] + (size_t)l * 1024}; }
    else if (r < 432) { const int q = r - 304, tn = q >> 2, kg = q & 3; u = ConvUnit{p->in[16] + (size_t)l * 1024 * 2048, wl + WXKV_O, 2048, kg * 256, tn * 64, 1024, tn * 64, nullptr}; }
    else if (r < 496) { const int q = r - 432, tn = q >> 2, kg = q & 3; u = ConvUnit{p->in[17] + (size_t)l * 1024 * 1024, wl + WXO_O, 1024, kg * 256, tn * 64, 1024, tn * 64, nullptr}; }
    else if (r < 848) { const int q = r - 496, tn = q >> 2, kg = q & 3; const int n0 = tn * 64, isup = n0 >= DFF, j0 = isup ? n0 - DFF : n0;
        u = ConvUnit{p->in[20] + (size_t)l * 1024 * 2 * DFF, wl + WGU_O, 2 * DFF, kg * 256, n0, 1024, (j0 >> 7) * 256 + (isup ? 128 : 0) + (j0 & 127), p->in[19] + (size_t)l * 1024}; }
    else { const int q = r - 848, tn = q / 11, kg = q % 11; u = ConvUnit{p->in[21] + (size_t)l * DFF * 1024, wl + WDN_O, 1024, kg * 256, tn * 64, DFF, tn * 64, nullptr}; }
    return u;
}
__device__ __forceinline__ void conv_load(const ConvUnit& u, int tid, float4 (&v)[4][2]) {
#pragma unroll
    for (int i = 0; i < 4; ++i) { const int idx = tid + 512 * i, rp = idx >> 4, c4 = (idx & 15) * 4;
#pragma unroll
        for (int h = 0; h < 2; ++h) { const int r = 2 * rp + h; v[i][h] = make_float4(0.f, 0.f, 0.f, 0.f);
            if (u.n0 + c4 < u.Nsrc) { const f32x4 t4 = __builtin_nontemporal_load((const f32x4*)(u.src + (size_t)(u.k0 + r) * u.Nsrc + u.n0 + c4)); const float g = u.gk ? u.gk[u.k0 + r] : 1.0f;
                v[i][h] = make_float4(t4[0] * g, t4[1] * g, t4[2] * g, t4[3] * g); } } }
}
__device__ void phase_convert_weights(KP p, float* sT_, int wv) {
    unsigned* sT = (unsigned*)sT_;
    const int tid = otid(wv); int t = blockIdx.x; if (t >= DEPTH * 1024) return;
    ConvUnit u = conv_decode(p, t); float4 v[4][2]; conv_load(u, tid, v);
    for (;;) {
#pragma unroll
        for (int i = 0; i < 4; ++i) { const int idx = tid + 512 * i, rp = idx >> 4, c4 = (idx & 15) * 4;
            sT[(c4 + 0) * 129 + rp] = cvt_pk_bf16(v[i][0].x, v[i][1].x); sT[(c4 + 1) * 129 + rp] = cvt_pk_bf16(v[i][0].y, v[i][1].y);
            sT[(c4 + 2) * 129 + rp] = cvt_pk_bf16(v[i][0].z, v[i][1].z); sT[(c4 + 3) * 129 + rp] = cvt_pk_bf16(v[i][0].w, v[i][1].w); }
        __syncthreads();
        const ConvUnit cu = u; const int tn = t + gridDim.x; const bool more = tn < DEPTH * 1024;
        if (more) { u = conv_decode(p, tn); conv_load(u, tid, v); }
#pragma unroll
        for (int i = 0; i < 4; ++i) { const int q = tid + 512 * i, nl = q & 63, kc = q >> 6;
            u32x4 w; w.x = sT[nl * 129 + kc * 4]; w.y = sT[nl * 129 + kc * 4 + 1]; w.z = sT[nl * 129 + kc * 4 + 2]; w.w = sT[nl * 129 + kc * 4 + 3];
            *(u32x4*)(cu.dst + (size_t)(cu.drow0 + nl) * cu.ldd + cu.k0 + kc * 8) = w; }
        __syncthreads();
        if (!more) break;
        t = tn;
    }
}
__device__ void rms_rows_bf16(const float* src, const float* g, bf16_t* dst, int nrows, int wv) {
    const int lane = otid(wv) & 63, gw = blockIdx.x * 8 + (otid(wv) >> 6), nw = gridDim.x * 8;
    for (int row0 = gw * 4; row0 < nrows; row0 += nw * 4) {
        float4 v[4][4];
#pragma unroll
        for (int r = 0; r < 4; ++r)
#pragma unroll
            for (int i = 0; i < 4; ++i) v[r][i] = ((const float4*)(src + (size_t)(row0 + r) * 1024))[i * 64 + lane];
#pragma unroll
        for (int r = 0; r < 4; ++r) { float ss = 0.f;
#pragma unroll
            for (int i = 0; i < 4; ++i) ss += v[r][i].x * v[r][i].x + v[r][i].y * v[r][i].y + v[r][i].z * v[r][i].z + v[r][i].w * v[r][i].w;
            ss = wave_sum(ss, lane); const float rs = rsqrtf(ss * (1.0f / 1024.0f) + EPS);
#pragma unroll
            for (int i = 0; i < 4; ++i) { const float4 gg = ((const float4*)g)[i * 64 + lane];
                u32x2 w; w.x = cvt_pk_bf16(v[r][i].x * rs * gg.x, v[r][i].y * rs * gg.y); w.y = cvt_pk_bf16(v[r][i].z * rs * gg.z, v[r][i].w * rs * gg.w);
                *(u32x2*)(dst + (size_t)(row0 + r) * 1024 + i * 256 + lane * 4) = w; } }
    }
}
__device__ void phase_x_init(const float* src, bf16_t* dst, float* rsout, int wv) {
    const int lane = otid(wv) & 63, gw = blockIdx.x * 8 + (otid(wv) >> 6), nw = gridDim.x * 8;
    for (int row0 = gw * 4; row0 < MTOK; row0 += nw * 4) {
        float4 v[4][4];
#pragma unroll
        for (int r = 0; r < 4; ++r)
#pragma unroll
            for (int i = 0; i < 4; ++i) v[r][i] = ((const float4*)(src + (size_t)(row0 + r) * 1024))[i * 64 + lane];
#pragma unroll
        for (int r = 0; r < 4; ++r) { float ss = 0.f;
#pragma unroll
            for (int i = 0; i < 4; ++i) { ss += v[r][i].x * v[r][i].x + v[r][i].y * v[r][i].y + v[r][i].z * v[r][i].z + v[r][i].w * v[r][i].w;
                u32x2 w; w.x = cvt_pk_bf16(v[r][i].x, v[r][i].y); w.y = cvt_pk_bf16(v[r][i].z, v[r][i].w);
                *(u32x2*)(dst + (size_t)(row0 + r) * 1024 + i * 256 + lane * 4) = w; }
            ss = wave_sum(ss, lane); if (lane == 0) rsout[row0 + r] = rsqrtf(ss * (1.0f / 1024.0f) + EPS); }
    }
}
template <bool XIN_BF, bool XOUT_BF>
__device__ void phase_norm_res(const bf16_t* y, const void* xin_, void* xout_, const float* gpost, float* rsout, int wv) {
    const int lane = otid(wv) & 63, gw = blockIdx.x * 8 + (otid(wv) >> 6), nw = gridDim.x * 8;
    for (int row0 = gw * 4; row0 < MTOK; row0 += nw * 4) {
        u32x2 yw[4][4]; float4 xv[4][4];
#pragma unroll
        for (int r = 0; r < 4; ++r)
#pragma unroll
            for (int i = 0; i < 4; ++i) { yw[r][i] = *(const u32x2*)(y + (size_t)(row0 + r) * 1024 + i * 256 + lane * 4);
                if (XIN_BF) { const u32x2 w = *(const u32x2*)((const bf16_t*)xin_ + (size_t)(row0 + r) * 1024 + i * 256 + lane * 4); xv[r][i] = make_float4(bf_lo(w.x), bf_hi(w.x), bf_lo(w.y), bf_hi(w.y)); }
                else xv[r][i] = ((const float4*)((const float*)xin_ + (size_t)(row0 + r) * 1024))[i * 64 + lane]; }
#pragma unroll
        for (int r = 0; r < 4; ++r) { float ss = 0.f; float yv[4][4];
#pragma unroll
            for (int i = 0; i < 4; ++i) { yv[i][0] = bf_lo(yw[r][i].x); yv[i][1] = bf_hi(yw[r][i].x); yv[i][2] = bf_lo(yw[r][i].y); yv[i][3] = bf_hi(yw[r][i].y);
#pragma unroll
                for (int e = 0; e < 4; ++e) ss += yv[i][e] * yv[i][e]; }
            ss = wave_sum(ss, lane); const float rs = rsqrtf(ss * (1.0f / 1024.0f) + EPS); float s2 = 0.f;
#pragma unroll
            for (int i = 0; i < 4; ++i) { const float4 gg = ((const float4*)gpost)[i * 64 + lane]; float4& x = xv[r][i];
                x.x += yv[i][0] * rs * gg.x; x.y += yv[i][1] * rs * gg.y; x.z += yv[i][2] * rs * gg.z; x.w += yv[i][3] * rs * gg.w;
                s2 += x.x * x.x + x.y * x.y + x.z * x.z + x.w * x.w;
                if (XOUT_BF) { u32x2 w; w.x = cvt_pk_bf16(x.x, x.y); w.y = cvt_pk_bf16(x.z, x.w); *(u32x2*)((bf16_t*)xout_ + (size_t)(row0 + r) * 1024 + i * 256 + lane * 4) = w; }
                else ((float4*)((float*)xout_ + (size_t)(row0 + r) * 1024))[i * 64 + lane] = x; }
            if (rsout) { s2 = wave_sum(s2, lane); if (lane == 0) rsout[row0 + r] = rsqrtf(s2 * (1.0f / 1024.0f) + EPS); } }
    }
}
__device__ __forceinline__ bf16x8 pack8(const float (&f)[8]) { u32x4 w; w.x = cvt_pk_bf16(f[0], f[1]); w.y = cvt_pk_bf16(f[2], f[3]); w.z = cvt_pk_bf16(f[4], f[5]); w.w = cvt_pk_bf16(f[6], f[7]); return __builtin_bit_cast(bf16x8, w); }
__device__ __forceinline__ void unpack8(const u32x4 w, float (&f)[8]) { f[0] = bf_lo(w.x); f[1] = bf_hi(w.x); f[2] = bf_lo(w.y); f[3] = bf_hi(w.y); f[4] = bf_lo(w.z); f[5] = bf_hi(w.z); f[6] = bf_lo(w.w); f[7] = bf_hi(w.w); }

__device__ void phase_gla_chunk(KP p, int l, LAS unsigned char* lds, int wv) {
    asm volatile("" : "+s"(p));
    const bf16_t* H = (const bf16_t*)(p->ws + WS_H); bf16_t* UB = (bf16_t*)(p->ws + WS_Y); float* AC = (float*)(p->ws + WS_AC);
    const float* wg = p->in[4] + (size_t)l * 16 * 256; const float* bg = p->in[5] + (size_t)l * 256;
    const int tid = otid(wv), lane = tid & 63, fr = lane & 15, fq = lane >> 4, c = tid & 63, seg = tid >> 6;
    int u = blockIdx.x; if (u >= 2048) return;
    u32x4 aw = (u32x4){0u, 0u, 0u, 0u}; u32x4 vw[2]; bf16_t kn[8];
#define GC_LOAD(uu) do { const int hd_ = (uu) & 3, n_ = ((uu) >> 2) & 63, b_ = (uu) >> 8; const size_t t0_ = (size_t)b_ * SEQ + n_ * 64; \
        if (tid < 128) aw = *(const u32x4*)(H + (t0_ + (tid >> 1)) * DINP + OFF_A + (tid & 1) * 8); \
        _Pragma("unroll") for (int i = 0; i < 2; ++i) { const int idx = tid + 512 * i; vw[i] = *(const u32x4*)(H + (t0_ + (idx & 63)) * DINP + OFF_V + hd_ * 128 + (idx >> 6) * 8); } \
        _Pragma("unroll") for (int i = 0; i < 8; ++i) kn[i] = H[(t0_ + seg * 8 + i) * DINP + OFF_K + hd_ * 64 + c]; } while (0)
    GC_LOAD(u);
    int hd_prev = -1; float wr_[16]; float bgc = 0.f;
#pragma unroll
    for (int r = 0; r < 16; ++r) wr_[r] = 0.f;
    for (int it = 0;; ++it) {
        LAS float* sA = (LAS float*)(lds + (it & 1) * 33792); LAS float* sTot = sA + 1024; LAS bf16_t* kdT = (LAS bf16_t*)(sTot + 512); LAS bf16_t* vT = kdT + 64 * 72;
        const int hd = u & 3;
        if (hd != hd_prev) { hd_prev = hd; bgc = bg[hd * 64 + c];
#pragma unroll
            for (int r = 0; r < 16; ++r) wr_[r] = wg[r * 256 + hd * 64 + c]; }
        if (tid < 128) { float f[8]; unpack8(aw, f); LAS float* d = sA + (tid >> 1) * 16 + (tid & 1) * 8; *(LAS f32x4*)d = (f32x4){f[0], f[1], f[2], f[3]}; *(LAS f32x4*)(d + 4) = (f32x4){f[4], f[5], f[6], f[7]}; }
#pragma unroll
        for (int i = 0; i < 2; ++i) { const int idx = tid + 512 * i, tok = idx & 63, c8 = (idx >> 6) * 8; const unsigned ww[4] = {vw[i].x, vw[i].y, vw[i].z, vw[i].w};
#pragma unroll
            for (int j = 0; j < 8; ++j) vT[(c8 + j) * 72 + tok] = (bf16_t)((j & 1) ? (ww[j >> 1] >> 16) : (ww[j >> 1] & 0xffffu)); }
        float kk[8];
#pragma unroll
        for (int i = 0; i < 8; ++i) kk[i] = bf2f(kn[i]);
        __syncthreads();
        const int un = u + gridDim.x; const bool more = un < 2048;
        if (more) GC_LOAD(un);
        float cl[8]; float run = 0.f;
#pragma unroll
        for (int i = 0; i < 8; ++i) { const LAS float* a = sA + (seg * 8 + i) * 16; float z = bgc;
#pragma unroll
            for (int r = 0; r < 16; ++r) z += a[r] * wr_[r];
            run += logsigmoid_f(z) * (1.0f / 16.0f); cl[i] = run; }
        sTot[seg * 64 + c] = run;
        __syncthreads();
        float pre = 0.f, tot = 0.f;
#pragma unroll
        for (int s = 0; s < 8; ++s) { const float v = sTot[s * 64 + c]; tot += v; if (s < seg) pre += v; }
        { float kd[8];
#pragma unroll
            for (int i = 0; i < 8; ++i) kd[i] = kk[i] * __expf(tot - (pre + cl[i]));
            *(LAS bf16x8*)(kdT + c * 72 + seg * 8) = pack8(kd); }
        if (seg == 0) AC[(size_t)u * 64 + c] = __expf(tot);
        __syncthreads();
        { bf16x8 bv[2];
#pragma unroll
            for (int ks = 0; ks < 2; ++ks) bv[ks] = *(const LAS bf16x8*)(vT + (wv * 16 + fr) * 72 + (ks * 4 + fq) * 8);
            bf16_t* ub = UB + (size_t)u * 8192 + (wv * 16 + fr) * 64 + fq * 4;
#pragma unroll
            for (int mt = 0; mt < 4; ++mt) { f32x4 acc = (f32x4){0.f, 0.f, 0.f, 0.f};
#pragma unroll
                for (int ks = 0; ks < 2; ++ks) { const bf16x8 av = *(const LAS bf16x8*)(kdT + (mt * 16 + fr) * 72 + (ks * 4 + fq) * 8);
                    acc = __builtin_amdgcn_mfma_f32_16x16x32_bf16(av, bv[ks], acc, 0, 0, 0); }
                u32x2 w; w.x = cvt_pk_bf16(acc[0], acc[1]); w.y = cvt_pk_bf16(acc[2], acc[3]); *(u32x2*)(ub + mt * 16) = w; } }
        if (!more) break;
        u = un;
    }
#undef GC_LOAD
    __syncthreads();
}
__device__ void phase_gla_scan(KP p, int wv) {
    asm volatile("" : "+s"(p));
    unsigned* UB = (unsigned*)(p->ws + WS_Y); const float* AC = (const float*)(p->ws + WS_AC);
    for (int e = blockIdx.x * 512 + otid(wv); e < 131072; e += gridDim.x * 512) {
        const int k2 = e & 31, v = (e >> 5) & 127, hd = (e >> 12) & 3, b = e >> 14;
        unsigned* ub = UB + (((size_t)b * 256 + hd) * 8192 + v * 64 + k2 * 2) / 2; const float* ab = AC + ((size_t)b * 256 + hd) * 64 + k2 * 2;
        float2 s = make_float2(0.f, 0.f);
        for (int n0 = 0; n0 < 64; n0 += 32) { unsigned uu[32]; float2 aa[32];
#pragma unroll
            for (int j = 0; j < 32; ++j) { uu[j] = ub[(size_t)(n0 + j) * 16384]; aa[j] = *(const float2*)(ab + (n0 + j) * 256); }
#pragma unroll
            for (int j = 0; j < 32; ++j) { s.x = aa[j].x * s.x + bf_lo(uu[j]); s.y = aa[j].y * s.y + bf_hi(uu[j]); ub[(size_t)(n0 + j) * 16384] = cvt_pk_bf16(s.x, s.y); } }
    }
}
__device__ void phase_gla_out(KP p, int l, LAS unsigned char* lds, int wv) {
    asm volatile("" : "+s"(p));
    LAS float* sO0 = (LAS float*)lds;
    const bf16_t* H = (const bf16_t*)(p->ws + WS_H); const bf16_t* UB = (const bf16_t*)(p->ws + WS_Y); bf16_t* MIX = (bf16_t*)p->out;
    const float* onorm = p->in[6] + (size_t)l * 512; const int tid = otid(wv), lane = tid & 63, fr = lane & 15, fq = lane >> 4;
    const int tt = tid >> 3, v0 = (tid & 7) * 16;
    int u = blockIdx.x; if (u >= 2048) return;
    bf16x8 bsn[2]; bf16x8 av[4][2]; u32x4 gw[2];
#define GO_LOAD(uu) do { const int hd_ = (uu) & 3, n_ = ((uu) >> 2) & 63, b_ = (uu) >> 8; const size_t t0_ = (size_t)b_ * SEQ + n_ * 64; \
        _Pragma("unroll") for (int ks = 0; ks < 2; ++ks) bsn[ks] = *(const bf16x8*)(UB + (size_t)(uu) * 8192 + (wv * 16 + fr) * 64 + ks * 32 + fq * 8); \
        _Pragma("unroll") for (int mt = 0; mt < 4; ++mt) _Pragma("unroll") for (int ks = 0; ks < 2; ++ks) av[mt][ks] = *(const bf16x8*)(H + (t0_ + mt * 16 + fr) * DINP + OFF_Q + hd_ * 64 + ks * 32 + fq * 8); \
        _Pragma("unroll") for (int h8 = 0; h8 < 2; ++h8) gw[h8] = *(const u32x4*)(H + (t0_ + tt) * DINP + OFF_G + hd_ * 128 + v0 + h8 * 8); } while (0)
    GO_LOAD(u);
    for (int it = 0;; ++it) {
        LAS float* sO = sO0 + (it & 1) * (64 * 132);
        const int hd = u & 3, n = (u >> 2) & 63, b = u >> 8; const size_t t0 = (size_t)b * SEQ + n * 64;
        const bf16x8 bs[2] = {bsn[0], bsn[1]};
#pragma unroll
        for (int mt = 0; mt < 4; ++mt) { f32x4 acc = (f32x4){0.f, 0.f, 0.f, 0.f};
#pragma unroll
            for (int ks = 0; ks < 2; ++ks) acc = __builtin_amdgcn_mfma_f32_16x16x32_bf16(av[mt][ks], bs[ks], acc, 0, 0, 0);
#pragma unroll
            for (int e = 0; e < 4; ++e) sO[(mt * 16 + fq * 4 + e) * 132 + wv * 16 + fr] = acc[e] * 0.125f; }
        float g[2][8]; unpack8(gw[0], g[0]); unpack8(gw[1], g[1]);
        __syncthreads();
        const int un = u + gridDim.x; const bool more = un < 2048;
        if (more) GO_LOAD(un);
        { f32x4 o[4]; float ss = 0.f;
#pragma unroll
            for (int q = 0; q < 4; ++q) { o[q] = *(const LAS f32x4*)(sO + tt * 132 + v0 + q * 4); ss += o[q][0] * o[q][0] + o[q][1] * o[q][1] + o[q][2] * o[q][2] + o[q][3] * o[q][3]; }
            ss += shx(ss, 1, lane); ss += shx(ss, 2, lane); ss += shx(ss, 4, lane);
            const float rs = rsqrtf(ss * (1.0f / 128.0f) + EPS); bf16_t* op = MIX + (t0 + tt) * 1024 + hd * 128 + v0;
#pragma unroll
            for (int h8 = 0; h8 < 2; ++h8) { const float4 n0 = *(const float4*)(onorm + hd * 128 + v0 + h8 * 8), n1 = *(const float4*)(onorm + hd * 128 + v0 + h8 * 8 + 4);
                const f32x4 o0 = o[h8 * 2], o1 = o[h8 * 2 + 1];
                const float r[8] = {o0[0] * rs * n0.x * silu_f(g[h8][0]), o0[1] * rs * n0.y * silu_f(g[h8][1]), o0[2] * rs * n0.z * silu_f(g[h8][2]), o0[3] * rs * n0.w * silu_f(g[h8][3]),
                                    o1[0] * rs * n1.x * silu_f(g[h8][4]), o1[1] * rs * n1.y * silu_f(g[h8][5]), o1[2] * rs * n1.z * silu_f(g[h8][6]), o1[3] * rs * n1.w * silu_f(g[h8][7])};
                *(bf16x8*)(op + h8 * 8) = pack8(r); } }
        if (!more) break;
        u = un;
    }
#undef GO_LOAD
    __syncthreads();
}
__device__ void phase_sg(KP p, int l, LAS unsigned char* lds, int wv) {
    asm volatile("" : "+s"(p));
    LAS float* sStat = (LAS float*)lds; LAS bf16_t* svT0 = (LAS bf16_t*)(lds + 1024);
    const bf16_t* H = (const bf16_t*)(p->ws + WS_H); bf16_t* MIX = (bf16_t*)p->out;   const bf16_t* WSB = (const bf16_t*)(p->ws + WS_AC + 524288) + (size_t)l * 4 * 128 * 128;
    const float* lng = p->in[7] + (size_t)l * 512; const float* lnb = p->in[8] + (size_t)l * 512; const float* bsp = p->in[10] + (size_t)l * 4 * 128;
    const int tid = otid(wv), lane = tid & 63, fr = lane & 15, fq = lane >> 4;
    for (int u = blockIdx.x; u < 256; u += gridDim.x) {
        const size_t t0 = (size_t)u * 128;
        for (int tb = 0; tb < 16; tb += 8) { u32x4 w8[8];
#pragma unroll
            for (int j = 0; j < 8; ++j) w8[j] = *(const u32x4*)(H + (t0 + wv * 16 + tb + j) * DINP + OFF_SV + lane * 8);
            float s1[8], s2[8];
#pragma unroll
            for (int j = 0; j < 8; ++j) { float f[8]; unpack8(w8[j], f); s1[j] = 0.f; s2[j] = 0.f;
#pragma unroll
                for (int e = 0; e < 8; ++e) { const float x = gelu_tanh(f[e]); s1[j] += x; s2[j] += x * x; } }
#pragma unroll
            for (int o = 32; o > 0; o >>= 1)
#pragma unroll
                for (int j = 0; j < 8; ++j) { s1[j] += shx(s1[j], o, lane); s2[j] += shx(s2[j], o, lane); }
            if (lane < 8) { float m1 = s1[0], m2 = s2[0];
#pragma unroll
                for (int j = 1; j < 8; ++j) if (lane == j) { m1 = s1[j]; m2 = s2[j]; }
                const float mu = m1 * (1.0f / 512.0f), var = fmaxf(m2 * (1.0f / 512.0f) - mu * mu, 0.f);
                sStat[(wv * 16 + tb + lane) * 2] = mu; sStat[(wv * 16 + tb + lane) * 2 + 1] = rsqrtf(var + EPS); } }
        __syncthreads();
        u32x4 svw[4];
#pragma unroll
        for (int it = 0; it < 4; ++it) { const int idx = tid + 512 * it, j = idx & 127, c8 = (idx >> 7) * 8; svw[it] = *(const u32x4*)(H + (t0 + j) * DINP + OFF_SV + c8); }
        for (int g = 0; g < 4; ++g) {
            LAS bf16_t* svT = svT0 + (g & 1) * (128 * 136);
            const int i = wv * 16 + fr; const size_t tok = t0 + i;
            bf16x8 wb[4]; u32x2 uw[8];
#pragma unroll
            for (int ks = 0; ks < 4; ++ks) wb[ks] = *(const bf16x8*)(WSB + ((size_t)g * 128 + i) * 128 + ks * 32 + fq * 8);
#pragma unroll
            for (int mt = 0; mt < 8; ++mt) uw[mt] = *(const u32x2*)(H + tok * DINP + OFF_U + g * 128 + mt * 16 + fq * 4);
            const float bs = bsp[g * 128 + i];
#pragma unroll
            for (int it = 0; it < 4; ++it) { const int idx = tid + 512 * it, j = idx & 127, c8 = (idx >> 7) * 8; float f[8];
                unpack8(svw[it], f);
                const float mu = sStat[j * 2], rs = sStat[j * 2 + 1];
#pragma unroll
                for (int e = 0; e < 8; ++e) { const float o = (gelu_tanh(f[e]) - mu) * rs * lng[g * 128 + c8 + e] + lnb[g * 128 + c8 + e];
                    svT[(c8 + e) * 136 + j] = (bf16_t)(cvt_pk_bf16(o, 0.f) & 0xffffu); } }
            __syncthreads();
            if (g < 3) {
#pragma unroll
                for (int it = 0; it < 4; ++it) { const int idx = tid + 512 * it, j = idx & 127, c8 = (idx >> 7) * 8; svw[it] = *(const u32x4*)(H + (t0 + j) * DINP + OFF_SV + (g + 1) * 128 + c8); } }
            f32x4 acc[8];
#pragma unroll
            for (int mt = 0; mt < 8; ++mt) { acc[mt] = (f32x4){0.f, 0.f, 0.f, 0.f};
#pragma unroll
                for (int ks = 0; ks < 4; ++ks) if (ks < 2 || wv >= 4) {
                    const bf16x8 av = *(const LAS bf16x8*)(svT + (mt * 16 + fr) * 136 + ks * 32 + fq * 8);
                    acc[mt] = __builtin_amdgcn_mfma_f32_16x16x32_bf16(av, wb[ks], acc[mt], 0, 0, 0); } }
#pragma unroll
            for (int mt = 0; mt < 8; ++mt) { const int cc = g * 128 + mt * 16 + fq * 4;
                const float r0 = gelu_tanh(bf_lo(uw[mt].x)) * (acc[mt][0] + bs), r1 = gelu_tanh(bf_hi(uw[mt].x)) * (acc[mt][1] + bs);
                const float r2 = gelu_tanh(bf_lo(uw[mt].y)) * (acc[mt][2] + bs), r3 = gelu_tanh(bf_hi(uw[mt].y)) * (acc[mt][3] + bs);
                u32x2 w; w.x = cvt_pk_bf16(r0, r1); w.y = cvt_pk_bf16(r2, r3);
                *(u32x2*)(MIX + tok * 1024 + 512 + cc) = w; }
        }
        __syncthreads();
    }
}
__device__ void phase_convert_wsp(KP p, int wv) {
    asm volatile("" : "+s"(p));
    const float4* src = (const float4*)p->in[9]; u32x2* dst = (u32x2*)(p->ws + WS_AC + 524288);
    for (int i = blockIdx.x * 512 + otid(wv); i < DEPTH * 4 * 128 * 128 / 4; i += gridDim.x * 512) { const float4 v = src[i]; u32x2 w; w.x = cvt_pk_bf16(v.x, v.y); w.y = cvt_pk_bf16(v.z, v.w); dst[i] = w; }
}

#define XB_TMO      128
#define XB_XCNT(j)  (256  + 64 * (j))
#define XB_XSUB(j)  (1280 + 64 * (j))
#define XB_XGEN(j)  (2304 + 64 * (j))
#define XB_TOP      3328
#define XB_TOPGEN   3392
#define XCD_BAR_WORDS 3456
#define XB_SPIN_CAP (1u << 22)
__device__ __forceinline__ unsigned xb_ld(unsigned* p)              { return __hip_atomic_load(p, __ATOMIC_RELAXED, __HIP_MEMORY_SCOPE_AGENT); }
__device__ __forceinline__ unsigned xb_add(unsigned* p, unsigned v) { return __hip_atomic_fetch_add(p, v, __ATOMIC_RELAXED, __HIP_MEMORY_SCOPE_AGENT); }
__device__ __forceinline__ unsigned xb_xcc_id() { return (unsigned)__builtin_amdgcn_s_getreg((3 << 11) | 20) & 0xFu; }
#define XB_SPIN(cond, bar) do { unsigned _sp = 0; while (cond) { __builtin_amdgcn_s_sleep(1); \
    if ((++_sp & 255u) == 0u) { if (xb_ld(&(bar)[XB_TMO])) break; if (_sp > XB_SPIN_CAP) { atomicAdd(&(bar)[XB_TMO], 1u); break; } } } } while (0)
struct XcdBarrier { unsigned* bar; unsigned x; volatile LAS unsigned* st; };
__device__ __forceinline__ XcdBarrier xcd_barrier_post(unsigned* bar, volatile LAS unsigned* st) {
    XcdBarrier b; b.bar = bar; b.x = xb_xcc_id(); b.st = st;
    if (threadIdx.x == 0) (void)xb_add(&bar[XB_XCNT(b.x)], 1u);
    return b;
}
__device__ __forceinline__ void xcd_barrier_complete(unsigned* bar, unsigned x, unsigned& nloc, unsigned& nx) {
    const unsigned G = gridDim.x * gridDim.y * gridDim.z;
    unsigned sum, cnt, mine, sp = 0u;
    for (;;) {
        sum = 0u; cnt = 0u; mine = 0u;
#pragma unroll
        for (unsigned j = 0; j < 16; ++j) { const unsigned c = xb_ld(&bar[XB_XCNT(j)]); sum += c; cnt += (c > 0u) ? 1u : 0u; mine = (j == x) ? c : mine; }
        if (sum == G) break;
        __builtin_amdgcn_s_sleep(1);
        if ((++sp & 255u) == 0u) { if (xb_ld(&bar[XB_TMO])) break; if (sp > XB_SPIN_CAP) { atomicAdd(&bar[XB_TMO], 1u); break; } }
    }
    nloc = mine > 0u ? mine : 1u; nx = cnt > 0u ? cnt : 1u;
}
__device__ __forceinline__ void xcd_barrier(const XcdBarrier& b, const int tid) {
    asm volatile("s_waitcnt vmcnt(0)" ::: "memory");
    __syncthreads();
    if (tid == 0) {
        unsigned* bar = b.bar;
        __builtin_amdgcn_s_waitcnt(0);
        unsigned nloc = b.st[0], nx = b.st[1];
        if (nloc == 0u) { xcd_barrier_complete(bar, b.x, nloc, nx); b.st[0] = nloc; b.st[1] = nx; }
        const unsigned old = xb_add(&bar[XB_XSUB(b.x)], 1u);
        const unsigned gen = old / nloc;
        if (old + 1u == (gen + 1u) * nloc) {
            __builtin_amdgcn_fence(__ATOMIC_RELEASE, "agent");
            asm volatile("s_waitcnt vmcnt(0)" ::: "memory");
            const unsigned og = xb_add(&bar[XB_TOP], 1u);
            const unsigned tg = og / nx;
            if (og + 1u == (tg + 1u) * nx) xb_add(&bar[XB_TOPGEN], 1u);
            else XB_SPIN(xb_ld(&bar[XB_TOPGEN]) == tg, bar);
            __builtin_amdgcn_fence(__ATOMIC_ACQUIRE, "agent");
            xb_add(&bar[XB_XGEN(b.x)], 1u);
            asm volatile("s_waitcnt vmcnt(0)" ::: "memory");
        } else {
            XB_SPIN(xb_ld(&bar[XB_XGEN(b.x)]) == gen, bar);
            __builtin_amdgcn_fence(__ATOMIC_ACQUIRE, "agent");
            asm volatile("s_waitcnt vmcnt(0)" ::: "memory");
        }
    }
    __syncthreads();
}

__global__ void __launch_bounds__(512) fwd_megakernel(Params p_unused) {
    KP p = (KP)__builtin_amdgcn_kernarg_segment_ptr();
    extern __shared__ __attribute__((aligned(16))) unsigned char shm[];
    cg::grid_group grid = cg::this_grid();
    LAS unsigned char* lds = (LAS unsigned char*)shm; float* smf = (float*)shm;
    const int G = gridDim.x, c = blockIdx.x;
    volatile LAS unsigned* xbw = (volatile LAS unsigned*)(lds + LDS_MAIN);
    if (threadIdx.x < 4) xbw[threadIdx.x] = 0u;
    __syncthreads();
    const XcdBarrier xbar = xcd_barrier_post((unsigned*)(fresh(p)->ws + WS_BAR), xbw);
const int wv = __builtin_amdgcn_readfirstlane(threadIdx.x >> 6);
#define GSYNC() do { xcd_barrier(xbar, otid(wv)); if (PROBE & 16) xcd_barrier(xbar, otid(wv)); } while (0)
    bf16_t* W = (bf16_t*)(fresh(p)->ws + WS_W); bf16_t* KB = (bf16_t*)(fresh(p)->ws + WS_K); bf16_t* VT = (bf16_t*)(fresh(p)->ws + WS_VT);
    bf16_t* XN = (bf16_t*)(fresh(p)->ws + WS_XN); bf16_t* Hb = (bf16_t*)(fresh(p)->ws + WS_H); bf16_t* Yb = (bf16_t*)(fresh(p)->ws + WS_Y);
    bf16_t* MEMN = (bf16_t*)(fresh(p)->ws + WS_MEMN);
    float* RS = (float*)(fresh(p)->ws + WS_BAR + 65536);

    for (int rep = 0; rep < ((PROBE & 4) ? 2 : 1); ++rep) phase_convert_weights(fresh(p), smf, wv);
    phase_convert_wsp(fresh(p), wv);
    phase_x_init(fresh(p)->in[0], XN, RS, wv);
    for (int l = 0; l < DEPTH; ++l) rms_rows_bf16(fresh(p)->in[1], fresh(p)->in[14] + (size_t)l * 1024, MEMN + (size_t)l * 2048 * 1024, BATCH * NMEM, wv);
    GSYNC();
    if (fresh(p)->ws == nullptr) grid.sync();

    for (int l = 0; l < DEPTH; ++l) {
        const bf16_t* wl = W + (size_t)l * WL_SZ;
        for (int rep = 0; rep < ((PROBE & 1) ? 2 : 1); ++rep) { pg8::SchedInKV S{XN, wl + WIN_O, MEMN + (size_t)l * 2048 * 1024, wl + WXKV_O, l, G, c}; pg8::EpiBf16 E{(bf16_t*)fresh(p)->ws, RS}; pg8::gemm_phase<1024, 1024, 1024>(lds, S, E, wv); }
        GSYNC();
        for (int rep = 0; rep < ((PROBE & 2) ? 2 : 1); ++rep) phase_gla_chunk(fresh(p), l, lds, wv);
        GSYNC();
        for (int step = 0; step < 2; ++step) { if ((step ^ ((c >> 3) & 1)) == 0) phase_gla_scan(fresh(p), wv); else phase_sg(fresh(p), l, lds, wv); }
        GSYNC();
        for (int rep = 0; rep < ((PROBE & 2) ? 2 : 1); ++rep) phase_gla_out(fresh(p), l, lds, wv);
        GSYNC();
        for (int rep = 0; rep < ((PROBE & 1) ? 2 : 1); ++rep) { pg8::SchedStd<0> S{(const bf16_t*)fresh(p)->out, wl + WOUT_O, 128, 4, 1024, 1024, 1024, G, c}; pg8::EpiBf16 E{Yb}; pg8::gemm_phase<1024, 1024, 1024>(lds, S, E, wv); }
        GSYNC();
        phase_norm_res<true, true>(Yb, XN, XN, fresh(p)->in[12] + (size_t)l * 1024, RS, wv);
        GSYNC();
        #define LOCAL_SEAM() do { asm volatile("s_waitcnt vmcnt(0)" ::: "memory"); __syncthreads(); } while (0)
        for (int rep = 0; rep < ((PROBE & 1) ? 2 : 1); ++rep) { pg8::SchedAttn<2> S{XN, wl + WXQ_O, G, c}; pg8::EpiBf16 E{Yb, RS}; pg8::gemm_phase<1024, 1024, 1024>(lds, S, E, wv); }
        LOCAL_SEAM();
        for (int rep = 0; rep < ((PROBE & 1) ? 2 : 1); ++rep) { pg8::SchedAttn<0> S{Yb, KB + (size_t)l * 2048 * 1024, G, c}; pg8::EpiSoftmax E{Hb, 0.0625f * 1.4426950408889634f, (LAS float*)(lds + pg8::STAGE_BYTES)}; pg8::gemm_phase<1024, 1024, 256>(lds, S, E, wv); }
        LOCAL_SEAM();
        for (int rep = 0; rep < ((PROBE & 1) ? 2 : 1); ++rep) { pg8::SchedAttn<1> S{Hb, VT + (size_t)l * 8 * 1024 * 256, G, c}; pg8::EpiBf16 E{Yb}; pg8::gemm_phase<1024, 256, 256>(lds, S, E, wv); }
        GSYNC();
        for (int rep = 0; rep < ((PROBE & 1) ? 2 : 1); ++rep) { pg8::SchedStd<0> S{Yb, wl + WXO_O, 128, 4, 1024, 1024, 1024, G, c}; pg8::EpiBf16 E{Hb}; pg8::gemm_phase<1024, 1024, 1024>(lds, S, E, wv); }
        GSYNC();
        phase_norm_res<true, true>(Hb, XN, l + 1 < DEPTH ? (void*)XN : (void*)W, fresh(p)->in[18] + (size_t)l * 1024, RS, wv);
        GSYNC();
        for (int rep = 0; rep < ((PROBE & 1) ? 2 : 1); ++rep) { pg8::SchedStd<1> S{l + 1 < DEPTH ? (const bf16_t*)XN : (const bf16_t*)W, wl + WGU_O, 128, 22, 1024, 1024, DFF, G, c}; pg8::EpiSwiglu E{Hb, RS}; pg8::gemm_phase<1024, 1024, 1024>(lds, S, E, wv); }
        GSYNC();
        for (int rep = 0; rep < ((PROBE & 1) ? 2 : 1); ++rep) { pg8::SchedStd<0> S{Hb, wl + WDN_O, 128, 4, DFF, DFF, 1024, G, c}; pg8::EpiBf16 E{Yb}; pg8::gemm_phase<DFF, DFF, DFF>(lds, S, E, wv); }
        GSYNC();
        if (l + 1 < DEPTH) phase_norm_res<true, true>(Yb, XN, XN, fresh(p)->in[22] + (size_t)l * 1024, RS, wv);
        else phase_norm_res<true, false>(Yb, (const void*)W, fresh(p)->out, fresh(p)->in[22] + (size_t)l * 1024, nullptr, wv);
        if (l + 1 < DEPTH) GSYNC();
    }
}

extern "C" void kernel_launch(void* const* d_in, const int* in_sizes, int n_in, void* d_out, int out_size, void* d_ws, size_t ws_size, hipStream_t stream) {
    static int grid_blocks = 0;
    if (grid_blocks == 0) {
        if (n_in != 23 || ws_size < WS_END) { fprintf(stderr, "kernel_launch: unexpected n_in %d / ws_size %zu\n", n_in, ws_size); grid_blocks = -1; return; }
        int dev = 0, cus = 0, per_cu = 0;
        hipGetDevice(&dev);
        hipDeviceGetAttribute(&cus, hipDeviceAttributeMultiprocessorCount, dev);
        if (hipFuncSetAttribute((const void*)fwd_megakernel, hipFuncAttributeMaxDynamicSharedMemorySize, LDS_BYTES) != hipSuccess) { fprintf(stderr, "kernel_launch: hipFuncSetAttribute failed\n"); grid_blocks = -1; return; }
        if (hipOccupancyMaxActiveBlocksPerMultiprocessor(&per_cu, (const void*)fwd_megakernel, 512, LDS_BYTES) != hipSuccess || per_cu < 1) { fprintf(stderr, "kernel_launch: occupancy query failed (%d)\n", per_cu); (void)hipGetLastError(); per_cu = 1; }
        grid_blocks = cus * 1;
        fprintf(stderr, "kernel_launch: cus %d per_cu %d grid %d\n", cus, per_cu, grid_blocks);
    }
    if (grid_blocks < 0) return;
    if (hipMemsetAsync((char*)d_ws + WS_BAR, 0, XCD_BAR_WORDS * 4, stream) != hipSuccess) { fprintf(stderr, "kernel_launch: memset of barrier words failed\n"); return; }
    Params p{};
    for (int i = 0; i < 23; ++i) p.in[i] = (const float*)d_in[i];
    p.out = (float*)d_out; p.ws = (unsigned char*)d_ws;
    void* args[] = {&p};
    hipError_t e = hipLaunchCooperativeKernel((const void*)fwd_megakernel, dim3(grid_blocks), dim3(512), args, LDS_BYTES, stream);
    if (e != hipSuccess) fprintf(stderr, "cooperative launch failed: %s (grid %d)\n", hipGetErrorString(e), grid_blocks);
}
```

```cpp
#include <hip/hip_runtime.h>
#include <hip/hip_cooperative_groups.h>
#include <cstdio>
namespace cg = cooperative_groups;

#define LAS __attribute__((address_space(3)))
typedef unsigned short bf16_t;
typedef short bf16x8 __attribute__((ext_vector_type(8)));
typedef float f32x4 __attribute__((ext_vector_type(4)));
typedef unsigned u32x4 __attribute__((ext_vector_type(4)));
typedef unsigned u32x2 __attribute__((ext_vector_type(2)));

constexpr int BATCH = 8, SEQ = 4096, DM = 1024, MTOK = BATCH * SEQ, NMEM = 256, DEPTH = 4;
constexpr int DIN = 2576, DINP = 2816, DFF = 2816;
constexpr int OFF_Q = 0, OFF_K = 256, OFF_V = 512, OFF_G = 1024, OFF_A = 1536, OFF_U = 1552, OFF_SV = 2064;
constexpr float EPS = 1e-6f;
constexpr int PROBE = 0;

constexpr size_t WIN_O = 0, WOUT_O = 2883584, WXQ_O = 3932160, WXKV_O = 4980736, WXO_O = 7077888, WGU_O = 8126464, WDN_O = 13893632, WL_SZ = 16777216;
constexpr size_t MiB = 1048576;
constexpr size_t WS_W = 0, WS_K = 128 * MiB, WS_VT = 144 * MiB, WS_XN = 160 * MiB, WS_H = 224 * MiB, WS_Y = 400 * MiB, WS_AC = 464 * MiB, WS_BAR = 465 * MiB, WS_MEMN = 466 * MiB, WS_END = 482 * MiB;

constexpr int LDS_MAIN = 139264, LDS_BYTES = LDS_MAIN + 16;

struct Params {
    const float* in[23];
    float* out;
    unsigned char* ws;
};
typedef const __attribute__((address_space(4))) Params* KP;
__device__ __forceinline__ KP fresh(KP k) { asm volatile("" : "+s"(k)); return k; }

typedef __bf16 bf16v2 __attribute__((ext_vector_type(2)));
typedef float f32v2 __attribute__((ext_vector_type(2)));
__device__ __forceinline__ unsigned cvt_pk_bf16(float lo, float hi) { const f32v2 f = {lo, hi}; return __builtin_bit_cast(unsigned, __builtin_convertvector(f, bf16v2)); }
__device__ __forceinline__ int otid(int wv) { int t; asm volatile("v_mbcnt_lo_u32_b32 %0, -1, 0\n\tv_mbcnt_hi_u32_b32 %0, -1, %0\n\tv_lshl_add_u32 %0, %1, 6, %0" : "=&v"(t) : "s"(wv)); return t; }
__device__ __forceinline__ float bf_lo(unsigned w) { return __uint_as_float(w << 16); }
__device__ __forceinline__ float bf_hi(unsigned w) { return __uint_as_float(w & 0xffff0000u); }
__device__ __forceinline__ float bf2f(bf16_t b) { return __uint_as_float(((unsigned)b) << 16); }
__device__ __forceinline__ float shx(float v, int m, int lane) { return __int_as_float(__builtin_amdgcn_ds_bpermute((lane ^ m) << 2, __float_as_int(v))); }
__device__ __forceinline__ float wave_sum(float v, int lane) {
#pragma unroll
    for (int o = 32; o > 0; o >>= 1) v += shx(v, o, lane);
    return v;
}
__device__ __forceinline__ float gelu_tanh(float x) {
    const float y2 = 1.5957691216057308f * (x + 0.044715f * x * x * x);
    return x * __builtin_amdgcn_rcpf(1.0f + __expf(-y2));
}
__device__ __forceinline__ float silu_f(float x) { return x * __builtin_amdgcn_rcpf(1.0f + __expf(-x)); }
__device__ __forceinline__ float logsigmoid_f(float z) { return fminf(z, 0.0f) - __logf(1.0f + __expf(-fabsf(z))); }

namespace pg8 {
constexpr int BM = 256, BK = 64, HALF = 128, HTB = HALF * BK * 2, STAGE_BYTES = 8 * HTB, NXCD = 8, WGM = 8;
__device__ __forceinline__ int lds_byte(int r, int c) { const int st = (r >> 4) * 2 + (c >> 5), rr = r & 15, cc = c & 31, ob = rr * 64 + cc * 2; return st * 1024 + (ob ^ (((ob >> 9) & 1) << 5)); }
__device__ __forceinline__ void stage_rc(int b, int& R, int& C) { const int st = b / 1024, sb = b % 1024, swz = sb ^ (((sb >> 9) & 1) << 5); R = (st >> 1) * 16 + swz / 64; C = (st & 1) * 32 + (swz % 64) / 2; }
__device__ __forceinline__ int perm32(int rho) { const int n = rho >> 4, i = rho & 15; return 8 * (i >> 2) + 4 * n + (i & 3); }

struct Unit { const char* a; const char* b; size_t o; int ldc; int row0; };

__device__ __forceinline__ bool std_tile(int i, int G, int c, int nM, int nN, int& pm, int& pn) {
    const int nwg = nM * nN; const long L = (long)i * G + c; if (L >= nwg) return false;
    int wgid = (int)L; { const int q = nwg / NXCD, r = nwg % NXCD, xcd = wgid % NXCD, off = wgid / NXCD; wgid = (xcd < r ? xcd * (q + 1) : r * (q + 1) + (xcd - r) * q) + off; }
    const int nig = WGM * nN, gid = wgid / nig, fm = gid * WGM, gsz = (nM - fm) < WGM ? (nM - fm) : WGM;
    pm = fm + ((wgid % nig) % gsz); pn = (wgid % nig) / gsz; return true;
}
template <int MODE> struct SchedStd {
    const bf16_t* A; const bf16_t* Bt; int nM, nN, lda, ldb, ldc, G, c;
    __device__ __forceinline__ bool next(int i, Unit& u) const {
        int pm, pn; if (!std_tile(i, G, c, nM, nN, pm, pn)) return false;
        u.a = (const char*)(A + (size_t)pm * 256 * lda); u.b = (const char*)(Bt + (size_t)pn * 256 * ldb);
        u.o = (size_t)pm * 256 * ldc + (size_t)pn * (MODE == 1 ? 128 : 256); u.ldc = ldc; u.row0 = pm * 256; return true;
    }
};
struct SchedInKV {
    const bf16_t* A; const bf16_t* Bt; const bf16_t* memn; const bf16_t* Wkv; int l, G, c;
    __device__ __forceinline__ bool next(int i, Unit& u) const {
        int pm, pn;
        if (std_tile(i, G, c, 128, 11, pm, pn)) { u.a = (const char*)(A + (size_t)pm * 256 * 1024); u.b = (const char*)(Bt + (size_t)pn * 256 * 1024);
            u.o = WS_H / 2 + (size_t)pm * 256 * DINP + (size_t)pn * 256; u.ldc = DINP; u.row0 = pm * 256; return true; }
        const long r = (long)i * G + c - 1408; if (r >= 64) return false;
        u.row0 = -1;
        if (r < 32) { const int b = (int)r >> 2, pn2 = (int)r & 3; u.a = (const char*)(memn + (size_t)b * 256 * 1024); u.b = (const char*)(Wkv + (size_t)pn2 * 256 * 1024);
            u.o = WS_K / 2 + ((size_t)l * 2048 + b * 256) * 1024 + pn2 * 256; u.ldc = 1024; }
        else { const int rr = (int)r - 32, pm2 = rr >> 3, b = rr & 7; u.a = (const char*)(Wkv + (size_t)(1024 + pm2 * 256) * 1024); u.b = (const char*)(memn + (size_t)b * 256 * 1024);
            u.o = WS_VT / 2 + (((size_t)l * 8 + b) * 1024 + pm2 * 256) * 256; u.ldc = 256; }
        return true;
    }
};
struct SchedKV {
    const bf16_t* memn; const bf16_t* W; size_t kbase, vbase; int G, c;
    __device__ __forceinline__ bool next(int i, Unit& u) const {
        const long L = (long)i * G + c; if (L >= 256) return false;
        const int l = (int)L >> 6, r = (int)L & 63; const bf16_t* wl = W + (size_t)l * WL_SZ + WXKV_O; const bf16_t* ml = memn + (size_t)l * 2048 * 1024;
        if (r < 32) { const int b = r >> 2, pn = r & 3; u.a = (const char*)(ml + (size_t)b * 256 * 1024); u.b = (const char*)(wl + (size_t)pn * 256 * 1024);
            u.o = kbase + ((size_t)l * 2048 + b * 256) * 1024 + pn * 256; u.ldc = 1024; u.row0 = 0; }
        else { const int rr = r - 32, pm = rr >> 3, b = rr & 7; u.a = (const char*)(wl + (size_t)(1024 + pm * 256) * 1024); u.b = (const char*)(ml + (size_t)b * 256 * 1024);
            u.o = vbase + (((size_t)l * 8 + b) * 1024 + pm * 256) * 256; u.ldc = 256; u.row0 = 0; }
        return true;
    }
};
template <int MODE> struct SchedAttn {
    const bf16_t* A; const bf16_t* Bm; int G, c;
    __device__ __forceinline__ bool next(int i, Unit& u) const {
        const long L = (long)i * G + c; if (L >= 512) return false;
        int pm = (int)L >> 2, h = (int)L & 3;
        if (G == 256) { pm = i * 64 + (c & 7) * 8 + (c >> 5); h = (c >> 3) & 3; }
        const int b = pm >> 4;
        u.a = (const char*)(A + (size_t)pm * 256 * 1024 + (MODE == 2 ? 0 : h * 256));
        u.b = MODE == 0 ? (const char*)(Bm + (size_t)b * 256 * 1024 + h * 256) : (MODE == 1 ? (const char*)(Bm + ((size_t)b * 1024 + h * 256) * 256) : (const char*)(Bm + (size_t)h * 256 * 1024));
        u.o = (size_t)pm * 256 * 1024 + h * 256; u.ldc = 1024; u.row0 = pm * 256; return true;
    }
};

struct EpiBf16 {
    static constexpr bool PERM = true, RSLDS = true; bf16_t* O; const float* rs = nullptr;
    __device__ __forceinline__ void operator()(const f32x4 (&acc)[2][2][4][2], const Unit& u, int wr, int wc, int fr, int fq, const LAS float* lrs) const {
        bf16_t* base = O + u.o + (size_t)(wr * 64 + fr) * u.ldc + wc * 32 + 8 * fq;
#pragma unroll
        for (int ai = 0; ai < 2; ++ai)
#pragma unroll
            for (int m = 0; m < 4; ++m) { bf16_t* rowp = base + (size_t)(ai * HALF + m * 16) * u.ldc; const float sc = (rs && u.row0 >= 0) ? lrs[ai * HALF + wr * 64 + m * 16 + fr] : 1.0f;
#pragma unroll
                for (int bj = 0; bj < 2; ++bj) { const f32x4 v0 = acc[ai][bj][m][0] * sc, v1 = acc[ai][bj][m][1] * sc;
                    u32x4 w; w.x = cvt_pk_bf16(v0[0], v0[1]); w.y = cvt_pk_bf16(v0[2], v0[3]); w.z = cvt_pk_bf16(v1[0], v1[1]); w.w = cvt_pk_bf16(v1[2], v1[3]);
                    *(u32x4*)(rowp + bj * HALF) = w; } }
    }
};
struct EpiSwiglu {
    static constexpr bool PERM = true, RSLDS = true; bf16_t* O; const float* rs;
    __device__ __forceinline__ void operator()(const f32x4 (&acc)[2][2][4][2], const Unit& u, int wr, int wc, int fr, int fq, const LAS float* lrs) const {
        bf16_t* base = O + u.o + (size_t)(wr * 64 + fr) * u.ldc + wc * 32 + 8 * fq;
#pragma unroll
        for (int ai = 0; ai < 2; ++ai)
#pragma unroll
            for (int m = 0; m < 4; ++m) { bf16_t* rowp = base + (size_t)(ai * HALF + m * 16) * u.ldc; const float sc = lrs[ai * HALF + wr * 64 + m * 16 + fr];
                float r[8];
#pragma unroll
                for (int n = 0; n < 2; ++n)
#pragma unroll
                    for (int e = 0; e < 4; ++e) r[n * 4 + e] = silu_f(acc[ai][0][m][n][e] * sc) * (acc[ai][1][m][n][e] * sc);
                u32x4 w; w.x = cvt_pk_bf16(r[0], r[1]); w.y = cvt_pk_bf16(r[2], r[3]); w.z = cvt_pk_bf16(r[4], r[5]); w.w = cvt_pk_bf16(r[6], r[7]);
                *(u32x4*)rowp = w; }
    }
};
struct EpiSoftmax {
    static constexpr bool PERM = true, RSLDS = false; bf16_t* O; float scale2; LAS float* st;
    __device__ __forceinline__ void operator()(f32x4 (&acc)[2][2][4][2], const Unit& u, int wr, int wc, int fr, int fq, const LAS float*) const {
#pragma unroll
        for (int ai = 0; ai < 2; ++ai)
#pragma unroll
            for (int m = 0; m < 4; ++m) { float mx = -3.0e38f;
#pragma unroll
                for (int bj = 0; bj < 2; ++bj)
#pragma unroll
                    for (int n = 0; n < 2; ++n)
#pragma unroll
                        for (int e = 0; e < 4; ++e) mx = fmaxf(mx, acc[ai][bj][m][n][e]);
                mx = fmaxf(mx, shx(mx, 16, fq * 16 + fr)); mx = fmaxf(mx, shx(mx, 32, fq * 16 + fr));
                if (fq == 0) st[(ai * HALF + wr * 64 + m * 16 + fr) * 4 + wc] = mx; }
        asm volatile("s_waitcnt lgkmcnt(0)" ::: "memory"); __builtin_amdgcn_s_barrier(); asm volatile("" ::: "memory");
#pragma unroll
        for (int ai = 0; ai < 2; ++ai)
#pragma unroll
            for (int m = 0; m < 4; ++m) { const int row = ai * HALF + wr * 64 + m * 16 + fr; const f32x4 m4 = *(const LAS f32x4*)(st + row * 4);
                const float mx = fmaxf(fmaxf(m4[0], m4[1]), fmaxf(m4[2], m4[3])); float sm = 0.f;
#pragma unroll
                for (int bj = 0; bj < 2; ++bj)
#pragma unroll
                    for (int n = 0; n < 2; ++n)
#pragma unroll
                        for (int e = 0; e < 4; ++e) { const float ex = __builtin_amdgcn_exp2f((acc[ai][bj][m][n][e] - mx) * scale2); acc[ai][bj][m][n][e] = ex; sm += ex; }
                sm += shx(sm, 16, fq * 16 + fr); sm += shx(sm, 32, fq * 16 + fr);
                if (fq == 0) st[1024 + row * 4 + wc] = sm; }
        asm volatile("s_waitcnt lgkmcnt(0)" ::: "memory"); __builtin_amdgcn_s_barrier(); asm volatile("" ::: "memory");
        bf16_t* base = O + u.o + (size_t)(wr * 64 + fr) * u.ldc + wc * 32 + 8 * fq;
#pragma unroll
        for (int ai = 0; ai < 2; ++ai)
#pragma unroll
            for (int m = 0; m < 4; ++m) { const int row = ai * HALF + wr * 64 + m * 16 + fr; const f32x4 s4 = *(const LAS f32x4*)(st + 1024 + row * 4);
                const float inv = 1.0f / ((s4[0] + s4[1]) + (s4[2] + s4[3])); bf16_t* rowp = base + (size_t)(ai * HALF + m * 16) * u.ldc;
#pragma unroll
                for (int bj = 0; bj < 2; ++bj) { const f32x4 v0 = acc[ai][bj][m][0] * inv, v1 = acc[ai][bj][m][1] * inv;
                    u32x4 w; w.x = cvt_pk_bf16(v0[0], v0[1]); w.y = cvt_pk_bf16(v0[2], v0[3]); w.z = cvt_pk_bf16(v1[0], v1[1]); w.w = cvt_pk_bf16(v1[2], v1[3]);
                    *(u32x4*)(rowp + bj * HALF) = w; } }
    }
};
struct EpiF32Scale {
    static constexpr bool PERM = false, RSLDS = false; float* O; float scale;
    __device__ __forceinline__ void operator()(const f32x4 (&acc)[2][2][4][2], const Unit& u, int wr, int wc, int fr, int fq, const LAS float*) const {
        float* base = O + u.o + (size_t)(wr * 64 + fr) * u.ldc + wc * 32 + 4 * fq;
#pragma unroll
        for (int ai = 0; ai < 2; ++ai)
#pragma unroll
            for (int m = 0; m < 4; ++m) { float* rowp = base + (size_t)(ai * HALF + m * 16) * u.ldc;
#pragma unroll
                for (int bj = 0; bj < 2; ++bj)
#pragma unroll
                    for (int n = 0; n < 2; ++n) *(f32x4*)(rowp + bj * HALF + n * 16) = acc[ai][bj][m][n] * scale; }
    }
};

template <int lda, int ldb, int K, class Epi, class Sched>
__device__ __forceinline__ void gemm_phase(LAS unsigned char* lds, const Sched& S, const Epi& E, const int wv) {
    const int tid = otid(wv), wid = __builtin_amdgcn_readfirstlane(tid >> 6), lane = tid & 63, wr = wid >> 2, wc = wid & 3, fr = lane & 15, fq = lane >> 4;
    const int nt = K / BK;
    unsigned voffA[2], voffB[2];
#pragma unroll
    for (int i = 0; i < 2; ++i) { int R, C; stage_rc(tid * 16 + i * 8192, R, C); const int Rb = Epi::PERM ? ((R & ~31) + perm32(R & 31)) : R;
        voffA[i] = (unsigned)(R * lda + C) * 2u; voffB[i] = (unsigned)(Rb * ldb + C) * 2u; }
    const size_t kstep = (size_t)(BK * 2);
    const size_t hstepA = (size_t)HALF * lda * 2, hstepB = (size_t)HALF * ldb * 2;
    const unsigned ldsw = (unsigned)wid * 1024u;
    const int aoff = lds_byte(wr * 64 + fr, fq * 8), boff = lds_byte(wc * 32 + fr, fq * 8);
#define PG8_SA(b, h) (((b) * 2 + (h)) * HTB)
#define PG8_SB(b, h) ((4 + (b) * 2 + (h)) * HTB)
#define PG8_STAGE(bufoff, gbase, voff) do { _Pragma("unroll") for (int _i = 0; _i < 2; ++_i) \
        __builtin_amdgcn_global_load_lds((const unsigned*)((const char*)(gbase) + (voff)[_i]), (LAS unsigned*)(lds + (bufoff) + ldsw + _i * 8192), 16, 0, 0); } while (0)
#define PG8_LDA(dst, b, h) do { _Pragma("unroll") for (int m = 0; m < 4; ++m) _Pragma("unroll") for (int k = 0; k < 2; ++k) dst[m][k] = *(const LAS bf16x8*)(lds + PG8_SA(b, h) + aoff + m * 2048 + k * 1024); } while (0)
#define PG8_LDB(dst, b, h) do { _Pragma("unroll") for (int n = 0; n < 2; ++n) _Pragma("unroll") for (int k = 0; k < 2; ++k) dst[n][k] = *(const LAS bf16x8*)(lds + PG8_SB(b, h) + boff + n * 2048 + k * 1024); } while (0)
#define PG8_MMA(ai, bj, At, Bt) do { __builtin_amdgcn_s_setprio(1); _Pragma("unroll") for (int m = 0; m < 4; ++m) _Pragma("unroll") for (int n = 0; n < 2; ++n) _Pragma("unroll") for (int k = 0; k < 2; ++k) \
        acc[ai][bj][m][n] = __builtin_amdgcn_mfma_f32_16x16x32_bf16(Bt[n][k], At[m][k], acc[ai][bj][m][n], 0, 0, 0); __builtin_amdgcn_s_setprio(0); } while (0)
#define PG8_WAIT_V(n) asm volatile("s_waitcnt vmcnt(" #n ")" ::: "memory")
#define PG8_WAIT_L(n) asm volatile("s_waitcnt lgkmcnt(" #n ")" ::: "memory")
#define PG8_BAR __builtin_amdgcn_s_barrier()
#define PG8_SCHED __builtin_amdgcn_sched_barrier(0)
    Unit cur, nxt; int ui = 0;
    if (!S.next(0, cur)) return;
    const char* cA = cur.a; const char* cB = cur.b;
    f32x4 acc[2][2][4][2];
#pragma unroll
    for (int a = 0; a < 2; ++a)
#pragma unroll
        for (int b = 0; b < 2; ++b)
#pragma unroll
            for (int m = 0; m < 4; ++m)
#pragma unroll
                for (int n = 0; n < 2; ++n) acc[a][b][m][n] = (f32x4){0.f, 0.f, 0.f, 0.f};
    bf16x8 At[4][2], B0[2][2], B1[2][2];
    PG8_STAGE(PG8_SB(0, 0), cB, voffB); PG8_STAGE(PG8_SB(0, 1), cB + hstepB, voffB); PG8_STAGE(PG8_SA(0, 0), cA, voffA); PG8_STAGE(PG8_SA(0, 1), cA + hstepA, voffA);
    if (wr == 1) PG8_BAR;
    PG8_WAIT_V(2); PG8_BAR;
    PG8_STAGE(PG8_SB(1, 0), cB + kstep, voffB); PG8_STAGE(PG8_SA(1, 0), cA + kstep, voffA); PG8_STAGE(PG8_SB(1, 1), cB + hstepB + kstep, voffB);
    PG8_WAIT_V(6); PG8_BAR;
    for (;;) {
        const bool has_next = S.next(ui + 1, nxt);
        const char* nA = has_next ? nxt.a : cA; const char* nB = has_next ? nxt.b : cB;
#pragma unroll 1
        for (int t = 0; t < nt; t += 2) {
            const bool last = (t == nt - 2);
            if constexpr (Epi::RSLDS) { if (t == 0 && wid < 4 && E.rs != nullptr && cur.row0 >= 0)
                __builtin_amdgcn_global_load_lds((const unsigned*)(E.rs + cur.row0 + wid * 64 + lane), (LAS unsigned*)(lds + STAGE_BYTES + (ui & 1) * 1024 + wid * 256), 4, 0, 0); }
            const char* a1 = cA + (size_t)(t + 1) * kstep;
            const char* a2 = last ? nA : cA + (size_t)(t + 2) * kstep; const char* b2 = last ? nB : cB + (size_t)(t + 2) * kstep;
            const char* a3 = a2 + kstep; const char* b3 = b2 + kstep;
            PG8_LDB(B0, 0, 0); PG8_LDB(B1, 0, 1); PG8_SCHED; PG8_LDA(At, 0, 0); PG8_STAGE(PG8_SA(1, 1), a1 + hstepA, voffA);
            PG8_WAIT_V(8); PG8_WAIT_L(0); PG8_BAR; PG8_MMA(0, 0, At, B0); PG8_MMA(0, 1, At, B1); PG8_BAR; PG8_SCHED;
            PG8_LDA(At, 0, 1); PG8_STAGE(PG8_SB(0, 0), b2, voffB); PG8_STAGE(PG8_SB(0, 1), b2 + hstepB, voffB); PG8_STAGE(PG8_SA(0, 0), a2, voffA);
            PG8_WAIT_V(8); PG8_WAIT_L(0); PG8_BAR; PG8_MMA(1, 0, At, B0); PG8_MMA(1, 1, At, B1); PG8_BAR; PG8_SCHED;
            PG8_LDB(B0, 1, 0); PG8_LDB(B1, 1, 1); PG8_SCHED; PG8_LDA(At, 1, 0); PG8_STAGE(PG8_SA(0, 1), a2 + hstepA, voffA);
            PG8_WAIT_V(8); PG8_WAIT_L(0); PG8_BAR; PG8_MMA(0, 0, At, B0); PG8_MMA(0, 1, At, B1); PG8_BAR; PG8_SCHED;
            PG8_LDA(At, 1, 1); PG8_STAGE(PG8_SB(1, 0), b3, voffB); PG8_STAGE(PG8_SB(1, 1), b3 + hstepB, voffB); PG8_STAGE(PG8_SA(1, 0), a3, voffA);
            PG8_WAIT_V(8); PG8_WAIT_L(0); PG8_BAR; PG8_MMA(1, 0, At, B0); PG8_MMA(1, 1, At, B1); PG8_BAR; PG8_SCHED;
        }
        if (wr == 0) PG8_BAR;
        { const int l2 = otid(wv) & 63; E(acc, cur, wr, wc, l2 & 15, l2 >> 4, (const LAS float*)(lds + STAGE_BYTES + (ui & 1) * 1024)); }
        if (!has_next) break;
#pragma unroll
        for (int a = 0; a < 2; ++a)
#pragma unroll
            for (int b = 0; b < 2; ++b)
#pragma unroll
                for (int m = 0; m < 4; ++m)
#pragma unroll
                    for (int n = 0; n < 2; ++n) acc[a][b][m][n] = (f32x4){0.f, 0.f, 0.f, 0.f};
        cur = nxt; cA = nA; cB = nB; ++ui;
        if (wr == 1) PG8_BAR;
    }
    PG8_WAIT_V(0);
    PG8_BAR;
#undef PG8_SA
#undef PG8_SB
#undef PG8_STAGE
#undef PG8_LDA
#undef PG8_LDB
#undef PG8_MMA
#undef PG8_WAIT_V
#undef PG8_WAIT_L
#undef PG8_BAR
#undef PG8_SCHED
}
}

struct ConvUnit { const float* src; bf16_t* dst; int Nsrc, k0, n0, ldd, drow0; const float* gk; };
__device__ __forceinline__ ConvUnit conv_decode(KP p, int t) {
    bf16_t* W = (bf16_t*)(p->ws + WS_W); const int l = t >> 10, r = t & 1023; bf16_t* wl = W + (size_t)l * WL_SZ; ConvUnit u;
    if (r < 176) { const int tn = r >> 2, kg = r & 3; u = ConvUnit{p->in[3] + (size_t)l * 1024 * DIN, wl + WIN_O, DIN, kg * 256, tn * 64, 1024, tn * 64, p->in[2] + (size_t)l * 1024}; }
    else if (r < 240) { const int q = r - 176, tn = q >> 2, kg = q & 3; u = ConvUnit{p->in[11] + (size_t)l * 1024 * 1024, wl + WOUT_O, 1024, kg * 256, tn * 64, 1024, tn * 64, nullptr}; }
    else if (r < 304) { const int q = r - 240, tn = q >> 2, kg = q & 3; u = ConvUnit{p->in[15] + (size_t)l * 1024 * 1024, wl + WXQ_O, 1024, kg * 256, tn * 64, 1024, tn * 64, p->in[13] + (size_t)l * 1024}; }
    else if (r < 432) { const int q = r - 304, tn = q >> 2, kg = q & 3; u = ConvUnit{p->in[16] + (size_t)l * 1024 * 2048, wl + WXKV_O, 2048, kg * 256, tn * 64, 1024, tn * 64, nullptr}; }
    else if (r < 496) { const int q = r - 432, tn = q >> 2, kg = q & 3; u = ConvUnit{p->in[17] + (size_t)l * 1024 * 1024, wl + WXO_O, 1024, kg * 256, tn * 64, 1024, tn * 64, nullptr}; }
    else if (r < 848) { const int q = r - 496, tn = q >> 2, kg = q & 3; const int n0 = tn * 64, isup = n0 >= DFF, j0 = isup ? n0 - DFF : n0;
        u = ConvUnit{p->in[20] + (size_t)l * 1024 * 2 * DFF, wl + WGU_O, 2 * DFF, kg * 256, n0, 1024, (j0 >> 7) * 256 + (isup ? 128 : 0) + (j0 & 127), p->in[19] + (size_t)l * 1024}; }
    else { const int q = r - 848, tn = q / 11, kg = q % 11; u = ConvUnit{p->in[21] + (size_t)l * DFF * 1024, wl + WDN_O, 1024, kg * 256, tn * 64, DFF, tn * 64, nullptr}; }
    return u;
}
__device__ __forceinline__ void conv_load(const ConvUnit& u, int tid, float4 (&v)[4][2]) {
#pragma unroll
    for (int i = 0; i < 4; ++i) { const int idx = tid + 512 * i, rp = idx >> 4, c4 = (idx & 15) * 4;
#pragma unroll
        for (int h = 0; h < 2; ++h) { const int r = 2 * rp + h; v[i][h] = make_float4(0.f, 0.f, 0.f, 0.f);
            if (u.n0 + c4 < u.Nsrc) { const f32x4 t4 = __builtin_nontemporal_load((const f32x4*)(u.src + (size_t)(u.k0 + r) * u.Nsrc + u.n0 + c4)); const float g = u.gk ? u.gk[u.k0 + r] : 1.0f;
                v[i][h] = make_float4(t4[0] * g, t4[1] * g, t4[2] * g, t4[3] * g); } } }
}
__device__ void phase_convert_weights(KP p, float* sT_, int wv) {
    unsigned* sT = (unsigned*)sT_;
    const int tid = otid(wv); int t = blockIdx.x; if (t >= DEPTH * 1024) return;
    ConvUnit u = conv_decode(p, t); float4 v[4][2]; conv_load(u, tid, v);
    for (;;) {
#pragma unroll
        for (int i = 0; i < 4; ++i) { const int idx = tid + 512 * i, rp = idx >> 4, c4 = (idx & 15) * 4;
            sT[(c4 + 0) * 129 + rp] = cvt_pk_bf16(v[i][0].x, v[i][1].x); sT[(c4 + 1) * 129 + rp] = cvt_pk_bf16(v[i][0].y, v[i][1].y);
            sT[(c4 + 2) * 129 + rp] = cvt_pk_bf16(v[i][0].z, v[i][1].z); sT[(c4 + 3) * 129 + rp] = cvt_pk_bf16(v[i][0].w, v[i][1].w); }
        __syncthreads();
        const ConvUnit cu = u; const int tn = t + gridDim.x; const bool more = tn < DEPTH * 1024;
        if (more) { u = conv_decode(p, tn); conv_load(u, tid, v); }
#pragma unroll
        for (int i = 0; i < 4; ++i) { const int q = tid + 512 * i, nl = q & 63, kc = q >> 6;
            u32x4 w; w.x = sT[nl * 129 + kc * 4]; w.y = sT[nl * 129 + kc * 4 + 1]; w.z = sT[nl * 129 + kc * 4 + 2]; w.w = sT[nl * 129 + kc * 4 + 3];
            *(u32x4*)(cu.dst + (size_t)(cu.drow0 + nl) * cu.ldd + cu.k0 + kc * 8) = w; }
        __syncthreads();
        if (!more) break;
        t = tn;
    }
}
__device__ void rms_rows_bf16(const float* src, const float* g, bf16_t* dst, int nrows, int wv) {
    const int lane = otid(wv) & 63, gw = blockIdx.x * 8 + (otid(wv) >> 6), nw = gridDim.x * 8;
    for (int row0 = gw * 4; row0 < nrows; row0 += nw * 4) {
        float4 v[4][4];
#pragma unroll
        for (int r = 0; r < 4; ++r)
#pragma unroll
            for (int i = 0; i < 4; ++i) v[r][i] = ((const float4*)(src + (size_t)(row0 + r) * 1024))[i * 64 + lane];
#pragma unroll
        for (int r = 0; r < 4; ++r) { float ss = 0.f;
#pragma unroll
            for (int i = 0; i < 4; ++i) ss += v[r][i].x * v[r][i].x + v[r][i].y * v[r][i].y + v[r][i].z * v[r][i].z + v[r][i].w * v[r][i].w;
            ss = wave_sum(ss, lane); const float rs = rsqrtf(ss * (1.0f / 1024.0f) + EPS);
#pragma unroll
            for (int i = 0; i < 4; ++i) { const float4 gg = ((const float4*)g)[i * 64 + lane];
                u32x2 w; w.x = cvt_pk_bf16(v[r][i].x * rs * gg.x, v[r][i].y * rs * gg.y); w.y = cvt_pk_bf16(v[r][i].z * rs * gg.z, v[r][i].w * rs * gg.w);
                *(u32x2*)(dst + (size_t)(row0 + r) * 1024 + i * 256 + lane * 4) = w; } }
    }
}
__device__ void phase_x_init(const float* src, bf16_t* dst, float* rsout, int wv) {
    const int lane = otid(wv) & 63, gw = blockIdx.x * 8 + (otid(wv) >> 6), nw = gridDim.x * 8;
    for (int row0 = gw * 4; row0 < MTOK; row0 += nw * 4) {
        float4 v[4][4];
#pragma unroll
        for (int r = 0; r < 4; ++r)
#pragma unroll
            for (int i = 0; i < 4; ++i) v[r][i] = ((const float4*)(src + (size_t)(row0 + r) * 1024))[i * 64 + lane];
#pragma unroll
        for (int r = 0; r < 4; ++r) { float ss = 0.f;
#pragma unroll
            for (int i = 0; i < 4; ++i) { ss += v[r][i].x * v[r][i].x + v[r][i].y * v[r][i].y + v[r][i].z * v[r][i].z + v[r][i].w * v[r][i].w;
                u32x2 w; w.x = cvt_pk_bf16(v[r][i].x, v[r][i].y); w.y = cvt_pk_bf16(v[r][i].z, v[r][i].w);
                *(u32x2*)(dst + (size_t)(row0 + r) * 1024 + i * 256 + lane * 4) = w; }
            ss = wave_sum(ss, lane); if (lane == 0) rsout[row0 + r] = rsqrtf(ss * (1.0f / 1024.0f) + EPS); }
    }
}
template <bool XIN_BF, bool XOUT_BF>
__device__ void phase_norm_res(const bf16_t* y, const void* xin_, void* xout_, const float* gpost, float* rsout, int wv) {
    const int lane = otid(wv) & 63, gw = blockIdx.x * 8 + (otid(wv) >> 6), nw = gridDim.x * 8;
    for (int row0 = gw * 4; row0 < MTOK; row0 += nw * 4) {
        u32x2 yw[4][4]; float4 xv[4][4];
#pragma unroll
        for (int r = 0; r < 4; ++r)
#pragma unroll
            for (int i = 0; i < 4; ++i) { yw[r][i] = *(const u32x2*)(y + (size_t)(row0 + r) * 1024 + i * 256 + lane * 4);
                if (XIN_BF) { const u32x2 w = *(const u32x2*)((const bf16_t*)xin_ + (size_t)(row0 + r) * 1024 + i * 256 + lane * 4); xv[r][i] = make_float4(bf_lo(w.x), bf_hi(w.x), bf_lo(w.y), bf_hi(w.y)); }
                else xv[r][i] = ((const float4*)((const float*)xin_ + (size_t)(row0 + r) * 1024))[i * 64 + lane]; }
#pragma unroll
        for (int r = 0; r < 4; ++r) { float ss = 0.f; float yv[4][4];
#pragma unroll
            for (int i = 0; i < 4; ++i) { yv[i][0] = bf_lo(yw[r][i].x); yv[i][1] = bf_hi(yw[r][i].x); yv[i][2] = bf_lo(yw[r][i].y); yv[i][3] = bf_hi(yw[r][i].y);
#pragma unroll
                for (int e = 0; e < 4; ++e) ss += yv[i][e] * yv[i][e]; }
            ss = wave_sum(ss, lane); const float rs = rsqrtf(ss * (1.0f / 1024.0f) + EPS); float s2 = 0.f;
#pragma unroll
            for (int i = 0; i < 4; ++i) { const float4 gg = ((const float4*)gpost)[i * 64 + lane]; float4& x = xv[r][i];
                x.x += yv[i][0] * rs * gg.x; x.y += yv[i][1] * rs * gg.y; x.z += yv[i][2] * rs * gg.z; x.w += yv[i][3] * rs * gg.w;
                s2 += x.x * x.x + x.y * x.y + x.z * x.z + x.w * x.w;
                if (XOUT_BF) { u32x2 w; w.x = cvt_pk_bf16(x.x, x.y); w.y = cvt_pk_bf16(x.z, x.w); *(u32x2*)((bf16_t*)xout_ + (size_t)(row0 + r) * 1024 + i * 256 + lane * 4) = w; }
                else ((float4*)((float*)xout_ + (size_t)(row0 + r) * 1024))[i * 64 + lane] = x; }
            if (rsout) { s2 = wave_sum(s2, lane); if (lane == 0) rsout[row0 + r] = rsqrtf(s2 * (1.0f / 1024.0f) + EPS); } }
    }
}
__device__ __forceinline__ bf16x8 pack8(const float (&f)[8]) { u32x4 w; w.x = cvt_pk_bf16(f[0], f[1]); w.y = cvt_pk_bf16(f[2], f[3]); w.z = cvt_pk_bf16(f[4], f[5]); w.w = cvt_pk_bf16(f[6], f[7]); return __builtin_bit_cast(bf16x8, w); }
__device__ __forceinline__ void unpack8(const u32x4 w, float (&f)[8]) { f[0] = bf_lo(w.x); f[1] = bf_hi(w.x); f[2] = bf_lo(w.y); f[3] = bf_hi(w.y); f[4] = bf_lo(w.z); f[5] = bf_hi(w.z); f[6] = bf_lo(w.w); f[7] = bf_hi(w.w); }

__device__ void phase_gla_chunk(KP p, int l, LAS unsigned char* lds, int wv) {
    asm volatile("" : "+s"(p));
    const bf16_t* H = (const bf16_t*)(p->ws + WS_H); bf16_t* UB = (bf16_t*)(p->ws + WS_Y); float* AC = (float*)(p->ws + WS_AC);
    const float* wg = p->in[4] + (size_t)l * 16 * 256; const float* bg = p->in[5] + (size_t)l * 256;
    const int tid = otid(wv), lane = tid & 63, fr = lane & 15, fq = lane >> 4, c = tid & 63, seg = tid >> 6;
    int u = blockIdx.x; if (u >= 2048) return;
    u32x4 aw = (u32x4){0u, 0u, 0u, 0u}; u32x4 vw[2]; bf16_t kn[8];
#define GC_LOAD(uu) do { const int hd_ = (uu) & 3, n_ = ((uu) >> 2) & 63, b_ = (uu) >> 8; const size_t t0_ = (size_t)b_ * SEQ + n_ * 64; \
        if (tid < 128) aw = *(const u32x4*)(H + (t0_ + (tid >> 1)) * DINP + OFF_A + (tid & 1) * 8); \
        _Pragma("unroll") for (int i = 0; i < 2; ++i) { const int idx = tid + 512 * i; vw[i] = *(const u32x4*)(H + (t0_ + (idx & 63)) * DINP + OFF_V + hd_ * 128 + (idx >> 6) * 8); } \
        _Pragma("unroll") for (int i = 0; i < 8; ++i) kn[i] = H[(t0_ + seg * 8 + i) * DINP + OFF_K + hd_ * 64 + c]; } while (0)
    GC_LOAD(u);
    int hd_prev = -1; float wr_[16]; float bgc = 0.f;
#pragma unroll
    for (int r = 0; r < 16; ++r) wr_[r] = 0.f;
    for (int it = 0;; ++it) {
        LAS float* sA = (LAS float*)(lds + (it & 1) * 33792); LAS float* sTot = sA + 1024; LAS bf16_t* kdT = (LAS bf16_t*)(sTot + 512); LAS bf16_t* vT = kdT + 64 * 72;
        const int hd = u & 3;
        if (hd != hd_prev) { hd_prev = hd; bgc = bg[hd * 64 + c];
#pragma unroll
            for (int r = 0; r < 16; ++r) wr_[r] = wg[r * 256 + hd * 64 + c]; }
        if (tid < 128) { float f[8]; unpack8(aw, f); LAS float* d = sA + (tid >> 1) * 16 + (tid & 1) * 8; *(LAS f32x4*)d = (f32x4){f[0], f[1], f[2], f[3]}; *(LAS f32x4*)(d + 4) = (f32x4){f[4], f[5], f[6], f[7]}; }
#pragma unroll
        for (int i = 0; i < 2; ++i) { const int idx = tid + 512 * i, tok = idx & 63, c8 = (idx >> 6) * 8; const unsigned ww[4] = {vw[i].x, vw[i].y, vw[i].z, vw[i].w};
#pragma unroll
            for (int j = 0; j < 8; ++j) vT[(c8 + j) * 72 + tok] = (bf16_t)((j & 1) ? (ww[j >> 1] >> 16) : (ww[j >> 1] & 0xffffu)); }
        float kk[8];
#pragma unroll
        for (int i = 0; i < 8; ++i) kk[i] = bf2f(kn[i]);
        __syncthreads();
        const int un = u + gridDim.x; const bool more = un < 2048;
        if (more) GC_LOAD(un);
        float cl[8]; float run = 0.f;
#pragma unroll
        for (int i = 0; i < 8; ++i) { const LAS float* a = sA + (seg * 8 + i) * 16; float z = bgc;
#pragma unroll
            for (int r = 0; r < 16; ++r) z += a[r] * wr_[r];
            run += logsigmoid_f(z) * (1.0f / 16.0f); cl[i] = run; }
        sTot[seg * 64 + c] = run;
        __syncthreads();
        float pre = 0.f, tot = 0.f;
#pragma unroll
        for (int s = 0; s < 8; ++s) { const float v = sTot[s * 64 + c]; tot += v; if (s < seg) pre += v; }
        { float kd[8];
#pragma unroll
            for (int i = 0; i < 8; ++i) kd[i] = kk[i] * __expf(tot - (pre + cl[i]));
            *(LAS bf16x8*)(kdT + c * 72 + seg * 8) = pack8(kd); }
        if (seg == 0) AC[(size_t)u * 64 + c] = __expf(tot);
        __syncthreads();
        { bf16x8 bv[2];
#pragma unroll
            for (int ks = 0; ks < 2; ++ks) bv[ks] = *(const LAS bf16x8*)(vT + (wv * 16 + fr) * 72 + (ks * 4 + fq) * 8);
            bf16_t* ub = UB + (size_t)u * 8192 + (wv * 16 + fr) * 64 + fq * 4;
#pragma unroll
            for (int mt = 0; mt < 4; ++mt) { f32x4 acc = (f32x4){0.f, 0.f, 0.f, 0.f};
#pragma unroll
                for (int ks = 0; ks < 2; ++ks) { const bf16x8 av = *(const LAS bf16x8*)(kdT + (mt * 16 + fr) * 72 + (ks * 4 + fq) * 8);
                    acc = __builtin_amdgcn_mfma_f32_16x16x32_bf16(av, bv[ks], acc, 0, 0, 0); }
                u32x2 w; w.x = cvt_pk_bf16(acc[0], acc[1]); w.y = cvt_pk_bf16(acc[2], acc[3]); *(u32x2*)(ub + mt * 16) = w; } }
        if (!more) break;
        u = un;
    }
#undef GC_LOAD
    __syncthreads();
}
__device__ void phase_gla_scan(KP p, int wv) {
    asm volatile("" : "+s"(p));
    unsigned* UB = (unsigned*)(p->ws + WS_Y); const float* AC = (const float*)(p->ws + WS_AC);
    for (int e = blockIdx.x * 512 + otid(wv); e < 131072; e += gridDim.x * 512) {
        const int k2 = e & 31, v = (e >> 5) & 127, hd = (e >> 12) & 3, b = e >> 14;
        unsigned* ub = UB + (((size_t)b * 256 + hd) * 8192 + v * 64 + k2 * 2) / 2; const float* ab = AC + ((size_t)b * 256 + hd) * 64 + k2 * 2;
        float2 s = make_float2(0.f, 0.f);
        for (int n0 = 0; n0 < 64; n0 += 32) { unsigned uu[32]; float2 aa[32];
#pragma unroll
            for (int j = 0; j < 32; ++j) { uu[j] = ub[(size_t)(n0 + j) * 16384]; aa[j] = *(const float2*)(ab + (n0 + j) * 256); }
#pragma unroll
            for (int j = 0; j < 32; ++j) { s.x = aa[j].x * s.x + bf_lo(uu[j]); s.y = aa[j].y * s.y + bf_hi(uu[j]); ub[(size_t)(n0 + j) * 16384] = cvt_pk_bf16(s.x, s.y); } }
    }
}
__device__ void phase_gla_out(KP p, int l, LAS unsigned char* lds, int wv) {
    asm volatile("" : "+s"(p));
    LAS float* sO0 = (LAS float*)lds;
    const bf16_t* H = (const bf16_t*)(p->ws + WS_H); const bf16_t* UB = (const bf16_t*)(p->ws + WS_Y); bf16_t* MIX = (bf16_t*)(p->ws + WS_XN);
    const float* onorm = p->in[6] + (size_t)l * 512; const int tid = otid(wv), lane = tid & 63, fr = lane & 15, fq = lane >> 4;
    const int tt = tid >> 3, v0 = (tid & 7) * 16;
    int u = blockIdx.x; if (u >= 2048) return;
    bf16x8 bsn[2]; bf16x8 av[4][2]; u32x4 gw[2];
#define GO_LOAD(uu) do { const int hd_ = (uu) & 3, n_ = ((uu) >> 2) & 63, b_ = (uu) >> 8; const size_t t0_ = (size_t)b_ * SEQ + n_ * 64; \
        _Pragma("unroll") for (int ks = 0; ks < 2; ++ks) bsn[ks] = *(const bf16x8*)(UB + (size_t)(uu) * 8192 + (wv * 16 + fr) * 64 + ks * 32 + fq * 8); \
        _Pragma("unroll") for (int mt = 0; mt < 4; ++mt) _Pragma("unroll") for (int ks = 0; ks < 2; ++ks) av[mt][ks] = *(const bf16x8*)(H + (t0_ + mt * 16 + fr) * DINP + OFF_Q + hd_ * 64 + ks * 32 + fq * 8); \
        _Pragma("unroll") for (int h8 = 0; h8 < 2; ++h8) gw[h8] = *(const u32x4*)(H + (t0_ + tt) * DINP + OFF_G + hd_ * 128 + v0 + h8 * 8); } while (0)
    GO_LOAD(u);
    for (int it = 0;; ++it) {
        LAS float* sO = sO0 + (it & 1) * (64 * 132);
        const int hd = u & 3, n = (u >> 2) & 63, b = u >> 8; const size_t t0 = (size_t)b * SEQ + n * 64;
        const bf16x8 bs[2] = {bsn[0], bsn[1]};
#pragma unroll
        for (int mt = 0; mt < 4; ++mt) { f32x4 acc = (f32x4){0.f, 0.f, 0.f, 0.f};
#pragma unroll
            for (int ks = 0; ks < 2; ++ks) acc = __builtin_amdgcn_mfma_f32_16x16x32_bf16(av[mt][ks], bs[ks], acc, 0, 0, 0);
#pragma unroll
            for (int e = 0; e < 4; ++e) sO[(mt * 16 + fq * 4 + e) * 132 + wv * 16 + fr] = acc[e] * 0.125f; }
        float g[2][8]; unpack8(gw[0], g[0]); unpack8(gw[1], g[1]);
        __syncthreads();
        const int un = u + gridDim.x; const bool more = un < 2048;
        if (more) GO_LOAD(un);
        { f32x4 o[4]; float ss = 0.f;
#pragma unroll
            for (int q = 0; q < 4; ++q) { o[q] = *(const LAS f32x4*)(sO + tt * 132 + v0 + q * 4); ss += o[q][0] * o[q][0] + o[q][1] * o[q][1] + o[q][2] * o[q][2] + o[q][3] * o[q][3]; }
            ss += shx(ss, 1, lane); ss += shx(ss, 2, lane); ss += shx(ss, 4, lane);
            const float rs = rsqrtf(ss * (1.0f / 128.0f) + EPS); bf16_t* op = MIX + (t0 + tt) * 1024 + hd * 128 + v0;
#pragma unroll
            for (int h8 = 0; h8 < 2; ++h8) { const float4 n0 = *(const float4*)(onorm + hd * 128 + v0 + h8 * 8), n1 = *(const float4*)(onorm + hd * 128 + v0 + h8 * 8 + 4);
                const f32x4 o0 = o[h8 * 2], o1 = o[h8 * 2 + 1];
                const float r[8] = {o0[0] * rs * n0.x * silu_f(g[h8][0]), o0[1] * rs * n0.y * silu_f(g[h8][1]), o0[2] * rs * n0.z * silu_f(g[h8][2]), o0[3] * rs * n0.w * silu_f(g[h8][3]),
                                    o1[0] * rs * n1.x * silu_f(g[h8][4]), o1[1] * rs * n1.y * silu_f(g[h8][5]), o1[2] * rs * n1.z * silu_f(g[h8][6]), o1[3] * rs * n1.w * silu_f(g[h8][7])};
                *(bf16x8*)(op + h8 * 8) = pack8(r); } }
        if (!more) break;
        u = un;
    }
#undef GO_LOAD
    __syncthreads();
}
__device__ void phase_sg(KP p, int l, LAS unsigned char* lds, int wv) {
    asm volatile("" : "+s"(p));
    LAS float* sStat = (LAS float*)lds; LAS bf16_t* svT0 = (LAS bf16_t*)(lds + 1024);
    const bf16_t* H = (const bf16_t*)(p->ws + WS_H); bf16_t* MIX = (bf16_t*)(p->ws + WS_XN); const bf16_t* WSB = (const bf16_t*)(p->ws + WS_AC + 524288) + (size_t)l * 4 * 128 * 128;
    const float* lng = p->in[7] + (size_t)l * 512; const float* lnb = p->in[8] + (size_t)l * 512; const float* bsp = p->in[10] + (size_t)l * 4 * 128;
    const int tid = otid(wv), lane = tid & 63, fr = lane & 15, fq = lane >> 4;
    for (int u = blockIdx.x; u < 256; u += gridDim.x) {
        const size_t t0 = (size_t)u * 128;
        for (int tb = 0; tb < 16; tb += 8) { u32x4 w8[8];
#pragma unroll
            for (int j = 0; j < 8; ++j) w8[j] = *(const u32x4*)(H + (t0 + wv * 16 + tb + j) * DINP + OFF_SV + lane * 8);
            float s1[8], s2[8];
#pragma unroll
            for (int j = 0; j < 8; ++j) { float f[8]; unpack8(w8[j], f); s1[j] = 0.f; s2[j] = 0.f;
#pragma unroll
                for (int e = 0; e < 8; ++e) { const float x = gelu_tanh(f[e]); s1[j] += x; s2[j] += x * x; } }
#pragma unroll
            for (int o = 32; o > 0; o >>= 1)
#pragma unroll
                for (int j = 0; j < 8; ++j) { s1[j] += shx(s1[j], o, lane); s2[j] += shx(s2[j], o, lane); }
            if (lane < 8) { float m1 = s1[0], m2 = s2[0];
#pragma unroll
                for (int j = 1; j < 8; ++j) if (lane == j) { m1 = s1[j]; m2 = s2[j]; }
                const float mu = m1 * (1.0f / 512.0f), var = fmaxf(m2 * (1.0f / 512.0f) - mu * mu, 0.f);
                sStat[(wv * 16 + tb + lane) * 2] = mu; sStat[(wv * 16 + tb + lane) * 2 + 1] = rsqrtf(var + EPS); } }
        __syncthreads();
        u32x4 svw[4];
#pragma unroll
        for (int it = 0; it < 4; ++it) { const int idx = tid + 512 * it, j = idx & 127, c8 = (idx >> 7) * 8; svw[it] = *(const u32x4*)(H + (t0 + j) * DINP + OFF_SV + c8); }
        for (int g = 0; g < 4; ++g) {
            LAS bf16_t* svT = svT0 + (g & 1) * (128 * 136);
            const int i = wv * 16 + fr; const size_t tok = t0 + i;
            bf16x8 wb[4]; u32x2 uw[8];
#pragma unroll
            for (int ks = 0; ks < 4; ++ks) wb[ks] = *(const bf16x8*)(WSB + ((size_t)g * 128 + i) * 128 + ks * 32 + fq * 8);
#pragma unroll
            for (int mt = 0; mt < 8; ++mt) uw[mt] = *(const u32x2*)(H + tok * DINP + OFF_U + g * 128 + mt * 16 + fq * 4);
            const float bs = bsp[g * 128 + i];
#pragma unroll
            for (int it = 0; it < 4; ++it) { const int idx = tid + 512 * it, j = idx & 127, c8 = (idx >> 7) * 8; float f[8];
                unpack8(svw[it], f);
                const float mu = sStat[j * 2], rs = sStat[j * 2 + 1];
#pragma unroll
                for (int e = 0; e < 8; ++e) { const float o = (gelu_tanh(f[e]) - mu) * rs * lng[g * 128 + c8 + e] + lnb[g * 128 + c8 + e];
                    svT[(c8 + e) * 136 + j] = (bf16_t)(cvt_pk_bf16(o, 0.f) & 0xffffu); } }
            __syncthreads();
            if (g < 3) {
#pragma unroll
                for (int it = 0; it < 4; ++it) { const int idx = tid + 512 * it, j = idx & 127, c8 = (idx >> 7) * 8; svw[it] = *(const u32x4*)(H + (t0 + j) * DINP + OFF_SV + (g + 1) * 128 + c8); } }
            f32x4 acc[8];
#pragma unroll
            for (int mt = 0; mt < 8; ++mt) { acc[mt] = (f32x4){0.f, 0.f, 0.f, 0.f};
#pragma unroll
                for (int ks = 0; ks < 4; ++ks) if (ks < 2 || wv >= 4) {
                    const bf16x8 av = *(const LAS bf16x8*)(svT + (mt * 16 + fr) * 136 + ks * 32 + fq * 8);
                    acc[mt] = __builtin_amdgcn_mfma_f32_16x16x32_bf16(av, wb[ks], acc[mt], 0, 0, 0); } }
#pragma unroll
            for (int mt = 0; mt < 8; ++mt) { const int cc = g * 128 + mt * 16 + fq * 4;
                const float r0 = gelu_tanh(bf_lo(uw[mt].x)) * (acc[mt][0] + bs), r1 = gelu_tanh(bf_hi(uw[mt].x)) * (acc[mt][1] + bs);
                const float r2 = gelu_tanh(bf_lo(uw[mt].y)) * (acc[mt][2] + bs), r3 = gelu_tanh(bf_hi(uw[mt].y)) * (acc[mt][3] + bs);
                u32x2 w; w.x = cvt_pk_bf16(r0, r1); w.y = cvt_pk_bf16(r2, r3);
                *(u32x2*)(MIX + tok * 1024 + 512 + cc) = w; }
        }
        __syncthreads();
    }
}
__device__ void phase_convert_wsp(KP p, int wv) {
    asm volatile("" : "+s"(p));
    const float4* src = (const float4*)p->in[9]; u32x2* dst = (u32x2*)(p->ws + WS_AC + 524288);
    for (int i = blockIdx.x * 512 + otid(wv); i < DEPTH * 4 * 128 * 128 / 4; i += gridDim.x * 512) { const float4 v = src[i]; u32x2 w; w.x = cvt_pk_bf16(v.x, v.y); w.y = cvt_pk_bf16(v.z, v.w); dst[i] = w; }
}

#define XB_TMO      128
#define XB_XCNT(j)  (256  + 64 * (j))
#define XB_XSUB(j)  (1280 + 64 * (j))
#define XB_XGEN(j)  (2304 + 64 * (j))
#define XB_TOP      3328
#define XB_TOPGEN   3392
#define XCD_BAR_WORDS 3456
#define XB_SPIN_CAP (1u << 22)
__device__ __forceinline__ unsigned xb_ld(unsigned* p)              { return __hip_atomic_load(p, __ATOMIC_RELAXED, __HIP_MEMORY_SCOPE_AGENT); }
__device__ __forceinline__ unsigned xb_add(unsigned* p, unsigned v) { return __hip_atomic_fetch_add(p, v, __ATOMIC_RELAXED, __HIP_MEMORY_SCOPE_AGENT); }
__device__ __forceinline__ unsigned xb_xcc_id() { return (unsigned)__builtin_amdgcn_s_getreg((3 << 11) | 20) & 0xFu; }
#define XB_SPIN(cond, bar) do { unsigned _sp = 0; while (cond) { __builtin_amdgcn_s_sleep(1); \
    if ((++_sp & 255u) == 0u) { if (xb_ld(&(bar)[XB_TMO])) break; if (_sp > XB_SPIN_CAP) { atomicAdd(&(bar)[XB_TMO], 1u); break; } } } } while (0)
struct XcdBarrier { unsigned* bar; unsigned x; volatile LAS unsigned* st; };
__device__ __forceinline__ XcdBarrier xcd_barrier_post(unsigned* bar, volatile LAS unsigned* st) {
    XcdBarrier b; b.bar = bar; b.x = xb_xcc_id(); b.st = st;
    if (threadIdx.x == 0) (void)xb_add(&bar[XB_XCNT(b.x)], 1u);
    return b;
}
__device__ __forceinline__ void xcd_barrier_complete(unsigned* bar, unsigned x, unsigned& nloc, unsigned& nx) {
    const unsigned G = gridDim.x * gridDim.y * gridDim.z;
    unsigned sum, cnt, mine, sp = 0u;
    for (;;) {
        sum = 0u; cnt = 0u; mine = 0u;
#pragma unroll
        for (unsigned j = 0; j < 16; ++j) { const unsigned c = xb_ld(&bar[XB_XCNT(j)]); sum += c; cnt += (c > 0u) ? 1u : 0u; mine = (j == x) ? c : mine; }
        if (sum == G) break;
        __builtin_amdgcn_s_sleep(1);
        if ((++sp & 255u) == 0u) { if (xb_ld(&bar[XB_TMO])) break; if (sp > XB_SPIN_CAP) { atomicAdd(&bar[XB_TMO], 1u); break; } }
    }
    nloc = mine > 0u ? mine : 1u; nx = cnt > 0u ? cnt : 1u;
}
__device__ __forceinline__ void xcd_barrier(const XcdBarrier& b, const int tid) {
    asm volatile("s_waitcnt vmcnt(0)" ::: "memory");
    __syncthreads();
    if (tid == 0) {
        unsigned* bar = b.bar;
        __builtin_amdgcn_s_waitcnt(0);
        unsigned nloc = b.st[0], nx = b.st[1];
        if (nloc == 0u) { xcd_barrier_complete(bar, b.x, nloc, nx); b.st[0] = nloc; b.st[1] = nx; }
        const unsigned old = xb_add(&bar[XB_XSUB(b.x)], 1u);
        const unsigned gen = old / nloc;
        if (old + 1u == (gen + 1u) * nloc) {
            __builtin_amdgcn_fence(__ATOMIC_RELEASE, "agent");
            asm volatile("s_waitcnt vmcnt(0)" ::: "memory");
            const unsigned og = xb_add(&bar[XB_TOP], 1u);
            const unsigned tg = og / nx;
            if (og + 1u == (tg + 1u) * nx) xb_add(&bar[XB_TOPGEN], 1u);
            else XB_SPIN(xb_ld(&bar[XB_TOPGEN]) == tg, bar);
            __builtin_amdgcn_fence(__ATOMIC_ACQUIRE, "agent");
            xb_add(&bar[XB_XGEN(b.x)], 1u);
            asm volatile("s_waitcnt vmcnt(0)" ::: "memory");
        } else {
            XB_SPIN(xb_ld(&bar[XB_XGEN(b.x)]) == gen, bar);
            __builtin_amdgcn_fence(__ATOMIC_ACQUIRE, "agent");
            asm volatile("s_waitcnt vmcnt(0)" ::: "memory");
        }
    }
    __syncthreads();
}

__global__ void __launch_bounds__(512) fwd_megakernel(Params p_unused) {
    KP p = (KP)__builtin_amdgcn_kernarg_segment_ptr();
    extern __shared__ __attribute__((aligned(16))) unsigned char shm[];
    cg::grid_group grid = cg::this_grid();
    LAS unsigned char* lds = (LAS unsigned char*)shm; float* smf = (float*)shm;
    const int G = gridDim.x, c = blockIdx.x;
    volatile LAS unsigned* xbw = (volatile LAS unsigned*)(lds + LDS_MAIN);
    if (threadIdx.x < 4) xbw[threadIdx.x] = 0u;
    __syncthreads();
    const XcdBarrier xbar = xcd_barrier_post((unsigned*)(fresh(p)->ws + WS_BAR), xbw);
const int wv = __builtin_amdgcn_readfirstlane(threadIdx.x >> 6);
#define GSYNC() do { xcd_barrier(xbar, otid(wv)); if (PROBE & 16) xcd_barrier(xbar, otid(wv)); } while (0)
    bf16_t* W = (bf16_t*)(fresh(p)->ws + WS_W); bf16_t* KB = (bf16_t*)(fresh(p)->ws + WS_K); bf16_t* VT = (bf16_t*)(fresh(p)->ws + WS_VT);
    bf16_t* XN = (bf16_t*)(fresh(p)->ws + WS_XN); bf16_t* Hb = (bf16_t*)(fresh(p)->ws + WS_H); bf16_t* Yb = (bf16_t*)(fresh(p)->ws + WS_Y);
    bf16_t* MEMN = (bf16_t*)(fresh(p)->ws + WS_MEMN);
    float* RS = (float*)(fresh(p)->ws + WS_BAR + 65536);

    for (int rep = 0; rep < ((PROBE & 4) ? 2 : 1); ++rep) phase_convert_weights(fresh(p), smf, wv);
    phase_convert_wsp(fresh(p), wv);
    phase_x_init(fresh(p)->in[0], (bf16_t*)fresh(p)->out, RS, wv);
    for (int l = 0; l < DEPTH; ++l) rms_rows_bf16(fresh(p)->in[1], fresh(p)->in[14] + (size_t)l * 1024, MEMN + (size_t)l * 2048 * 1024, BATCH * NMEM, wv);
    GSYNC();
    if (fresh(p)->ws == nullptr) grid.sync();

    for (int l = 0; l < DEPTH; ++l) {
        const bf16_t* wl = W + (size_t)l * WL_SZ;
        for (int rep = 0; rep < ((PROBE & 1) ? 2 : 1); ++rep) { pg8::SchedInKV S{(const bf16_t*)fresh(p)->out, wl + WIN_O, MEMN + (size_t)l * 2048 * 1024, wl + WXKV_O, l, G, c}; pg8::EpiBf16 E{(bf16_t*)fresh(p)->ws, RS}; pg8::gemm_phase<1024, 1024, 1024>(lds, S, E, wv); }
        GSYNC();
        for (int rep = 0; rep < ((PROBE & 2) ? 2 : 1); ++rep) phase_gla_chunk(fresh(p), l, lds, wv);
        GSYNC();
        for (int step = 0; step < 2; ++step) { if ((step ^ ((c >> 3) & 1)) == 0) phase_gla_scan(fresh(p), wv); else phase_sg(fresh(p), l, lds, wv); }
        GSYNC();
        for (int rep = 0; rep < ((PROBE & 2) ? 2 : 1); ++rep) phase_gla_out(fresh(p), l, lds, wv);
        GSYNC();
        for (int rep = 0; rep < ((PROBE & 1) ? 2 : 1); ++rep) { pg8::SchedStd<0> S{XN, wl + WOUT_O, 128, 4, 1024, 1024, 1024, G, c}; pg8::EpiBf16 E{Yb}; pg8::gemm_phase<1024, 1024, 1024>(lds, S, E, wv); }
        GSYNC();
        phase_norm_res<true, true>(Yb, fresh(p)->out, fresh(p)->out, fresh(p)->in[12] + (size_t)l * 1024, RS, wv);
        GSYNC();
        #define LOCAL_SEAM() do { asm volatile("s_waitcnt vmcnt(0)" ::: "memory"); __syncthreads(); } while (0)
        for (int rep = 0; rep < ((PROBE & 1) ? 2 : 1); ++rep) { pg8::SchedAttn<2> S{(const bf16_t*)fresh(p)->out, wl + WXQ_O, G, c}; pg8::EpiBf16 E{Yb, RS}; pg8::gemm_phase<1024, 1024, 1024>(lds, S, E, wv); }
        LOCAL_SEAM();
        for (int rep = 0; rep < ((PROBE & 1) ? 2 : 1); ++rep) { pg8::SchedAttn<0> S{Yb, KB + (size_t)l * 2048 * 1024, G, c}; pg8::EpiSoftmax E{Hb, 0.0625f * 1.4426950408889634f, (LAS float*)(lds + pg8::STAGE_BYTES)}; pg8::gemm_phase<1024, 1024, 256>(lds, S, E, wv); }
        LOCAL_SEAM();
        for (int rep = 0; rep < ((PROBE & 1) ? 2 : 1); ++rep) { pg8::SchedAttn<1> S{Hb, VT + (size_t)l * 8 * 1024 * 256, G, c}; pg8::EpiBf16 E{Yb}; pg8::gemm_phase<1024, 256, 256>(lds, S, E, wv); }
        GSYNC();
        for (int rep = 0; rep < ((PROBE & 1) ? 2 : 1); ++rep) { pg8::SchedStd<0> S{Yb, wl + WXO_O, 128, 4, 1024, 1024, 1024, G, c}; pg8::EpiBf16 E{Hb}; pg8::gemm_phase<1024, 1024, 1024>(lds, S, E, wv); }
        GSYNC();
        phase_norm_res<true, true>(Hb, fresh(p)->out, l + 1 < DEPTH ? (void*)fresh(p)->out : (void*)W, fresh(p)->in[18] + (size_t)l * 1024, RS, wv);
        GSYNC();
        for (int rep = 0; rep < ((PROBE & 1) ? 2 : 1); ++rep) { pg8::SchedStd<1> S{l + 1 < DEPTH ? (const bf16_t*)fresh(p)->out : (const bf16_t*)W, wl + WGU_O, 128, 22, 1024, 1024, DFF, G, c}; pg8::EpiSwiglu E{Hb, RS}; pg8::gemm_phase<1024, 1024, 1024>(lds, S, E, wv); }
        GSYNC();
        for (int rep = 0; rep < ((PROBE & 1) ? 2 : 1); ++rep) { pg8::SchedStd<0> S{Hb, wl + WDN_O, 128, 4, DFF, DFF, 1024, G, c}; pg8::EpiBf16 E{Yb}; pg8::gemm_phase<DFF, DFF, DFF>(lds, S, E, wv); }
        GSYNC();
        if (l + 1 < DEPTH) phase_norm_res<true, true>(Yb, fresh(p)->out, fresh(p)->out, fresh(p)->in[22] + (size_t)l * 1024, RS, wv);
        else phase_norm_res<true, false>(Yb, (const void*)W, fresh(p)->out, fresh(p)->in[22] + (size_t)l * 1024, nullptr, wv);
        if (l + 1 < DEPTH) GSYNC();
    }
}

extern "C" void kernel_launch(void* const* d_in, const int* in_sizes, int n_in, void* d_out, int out_size, void* d_ws, size_t ws_size, hipStream_t stream) {
    static int grid_blocks = 0;
    if (grid_blocks == 0) {
        if (n_in != 23 || ws_size < WS_END) { fprintf(stderr, "kernel_launch: unexpected n_in %d / ws_size %zu\n", n_in, ws_size); grid_blocks = -1; return; }
        int dev = 0, cus = 0, per_cu = 0;
        hipGetDevice(&dev);
        hipDeviceGetAttribute(&cus, hipDeviceAttributeMultiprocessorCount, dev);
        if (hipFuncSetAttribute((const void*)fwd_megakernel, hipFuncAttributeMaxDynamicSharedMemorySize, LDS_BYTES) != hipSuccess) { fprintf(stderr, "kernel_launch: hipFuncSetAttribute failed\n"); grid_blocks = -1; return; }
        if (hipOccupancyMaxActiveBlocksPerMultiprocessor(&per_cu, (const void*)fwd_megakernel, 512, LDS_BYTES) != hipSuccess || per_cu < 1) { fprintf(stderr, "kernel_launch: occupancy query failed (%d)\n", per_cu); (void)hipGetLastError(); per_cu = 1; }
        grid_blocks = cus * 1;
        fprintf(stderr, "kernel_launch: cus %d per_cu %d grid %d\n", cus, per_cu, grid_blocks);
    }
    if (grid_blocks < 0) return;
    if (hipMemsetAsync((char*)d_ws + WS_BAR, 0, XCD_BAR_WORDS * 4, stream) != hipSuccess) { fprintf(stderr, "kernel_launch: memset of barrier words failed\n"); return; }
    Params p{};
    for (int i = 0; i < 23; ++i) p.in[i] = (const float*)d_in[i];
    p.out = (float*)d_out; p.ws = (unsigned char*)d_ws;
    void* args[] = {&p};
    hipError_t e = hipLaunchCooperativeKernel((const void*)fwd_megakernel, dim3(grid_blocks), dim3(512), args, LDS_BYTES, stream);
    if (e != hipSuccess) fprintf(stderr, "cooperative launch failed: %s (grid %d)\n", hipGetErrorString(e), grid_blocks);
}
```

```cpp
#include <hip/hip_runtime.h>
#include <hip/hip_cooperative_groups.h>
#include <cstdio>
namespace cg = cooperative_groups;

#define LAS __attribute__((address_space(3)))
typedef unsigned short bf16_t;
typedef short bf16x8 __attribute__((ext_vector_type(8)));
typedef float f32x4 __attribute__((ext_vector_type(4)));
typedef unsigned u32x4 __attribute__((ext_vector_type(4)));
typedef unsigned u32x2 __attribute__((ext_vector_type(2)));

constexpr int BATCH = 8, SEQ = 4096, DM = 1024, MTOK = BATCH * SEQ, NMEM = 256, DEPTH = 4;
constexpr int DIN = 2576, DINP = 2816, DFF = 2816;
constexpr int OFF_Q = 0, OFF_K = 256, OFF_V = 512, OFF_G = 1024, OFF_A = 1536, OFF_U = 1552, OFF_SV = 2064;
constexpr float EPS = 1e-6f;
constexpr int PROBE = 0;

constexpr size_t WIN_O = 0, WOUT_O = 2883584, WXQ_O = 3932160, WXKV_O = 4980736, WXO_O = 7077888, WGU_O = 8126464, WDN_O = 13893632, WL_SZ = 16777216;
constexpr size_t MiB = 1048576;
constexpr size_t WS_W = 0, WS_K = 128 * MiB, WS_VT = 144 * MiB, WS_XN = 160 * MiB, WS_H = 224 * MiB, WS_Y = 400 * MiB, WS_AC = 464 * MiB, WS_BAR = 465 * MiB, WS_MEMN = 466 * MiB, WS_END = 482 * MiB;

constexpr int LDS_MAIN = 139264, LDS_BYTES = LDS_MAIN + 16;

struct Params {
    const float* in[23];
    float* out;
    unsigned char* ws;
};
typedef const __attribute__((address_space(4))) Params* KP;
__device__ __forceinline__ KP fresh(KP k) { asm volatile("" : "+s"(k)); return k; }

typedef __bf16 bf16v2 __attribute__((ext_vector_type(2)));
typedef float f32v2 __attribute__((ext_vector_type(2)));
__device__ __forceinline__ unsigned cvt_pk_bf16(float lo, float hi) { const f32v2 f = {lo, hi}; return __builtin_bit_cast(unsigned, __builtin_convertvector(f, bf16v2)); }
__device__ __forceinline__ int otid(int wv) { int t; asm volatile("v_mbcnt_lo_u32_b32 %0, -1, 0\n\tv_mbcnt_hi_u32_b32 %0, -1, %0\n\tv_lshl_add_u32 %0, %1, 6, %0" : "=&v"(t) : "s"(wv)); return t; }
__device__ __forceinline__ float bf_lo(unsigned w) { return __uint_as_float(w << 16); }
__device__ __forceinline__ float bf_hi(unsigned w) { return __uint_as_float(w & 0xffff0000u); }
__device__ __forceinline__ float bf2f(bf16_t b) { return __uint_as_float(((unsigned)b) << 16); }
__device__ __forceinline__ float shx(float v, int m, int lane) { return __int_as_float(__builtin_amdgcn_ds_bpermute((lane ^ m) << 2, __float_as_int(v))); }
#define DPP_ADD(v, ctrl, rmask) ((v) + __int_as_float(__builtin_amdgcn_update_dpp(0, __float_as_int(v), (ctrl), (rmask), 0xf, false)))
__device__ __forceinline__ float row8_sum(float v) { v = DPP_ADD(v, 0xB1, 0xf); v = DPP_ADD(v, 0x4E, 0xf); v = DPP_ADD(v, 0x141, 0xf); return v; }
__device__ __forceinline__ float wave_sum(float v, int) {
    v = row8_sum(v); v = DPP_ADD(v, 0x140, 0xf); v = DPP_ADD(v, 0x142, 0xa); v = DPP_ADD(v, 0x143, 0xc);
    return __int_as_float(__builtin_amdgcn_readlane(__float_as_int(v), 63));
}
__device__ __forceinline__ float gelu_tanh(float x) {
    const float y2 = 1.5957691216057308f * (x + 0.044715f * x * x * x);
    return x * __builtin_amdgcn_rcpf(1.0f + __expf(-y2));
}
__device__ __forceinline__ float silu_f(float x) { return x * __builtin_amdgcn_rcpf(1.0f + __expf(-x)); }
__device__ __forceinline__ float logsigmoid_f(float z) { return fminf(z, 0.0f) - __logf(1.0f + __expf(-fabsf(z))); }

namespace pg8 {
constexpr int BM = 256, BK = 64, HALF = 128, HTB = HALF * BK * 2, STAGE_BYTES = 8 * HTB, NXCD = 8, WGM = 8;
__device__ __forceinline__ int lds_byte(int r, int c) { const int st = (r >> 4) * 2 + (c >> 5), rr = r & 15, cc = c & 31, ob = rr * 64 + cc * 2; return st * 1024 + (ob ^ (((ob >> 9) & 1) << 5)); }
__device__ __forceinline__ void stage_rc(int b, int& R, int& C) { const int st = b / 1024, sb = b % 1024, swz = sb ^ (((sb >> 9) & 1) << 5); R = (st >> 1) * 16 + swz / 64; C = (st & 1) * 32 + (swz % 64) / 2; }
__device__ __forceinline__ int perm32(int rho) { const int n = rho >> 4, i = rho & 15; return 8 * (i >> 2) + 4 * n + (i & 3); }

struct Unit { const char* a; const char* b; size_t o; int ldc; int row0; };

__device__ __forceinline__ bool std_tile(int i, int G, int c, int nM, int nN, int& pm, int& pn) {
    const int nwg = nM * nN; const long L = (long)i * G + c; if (L >= nwg) return false;
    int wgid = (int)L; { const int q = nwg / NXCD, r = nwg % NXCD, xcd = wgid % NXCD, off = wgid / NXCD; wgid = (xcd < r ? xcd * (q + 1) : r * (q + 1) + (xcd - r) * q) + off; }
    const int nig = WGM * nN, gid = wgid / nig, fm = gid * WGM, gsz = (nM - fm) < WGM ? (nM - fm) : WGM;
    pm = fm + ((wgid % nig) % gsz); pn = (wgid % nig) / gsz; return true;
}
template <int MODE> struct SchedStd {
    const bf16_t* A; const bf16_t* Bt; int nM, nN, lda, ldb, ldc, G, c;
    __device__ __forceinline__ bool next(int i, Unit& u) const {
        int pm, pn; if (!std_tile(i, G, c, nM, nN, pm, pn)) return false;
        u.a = (const char*)(A + (size_t)pm * 256 * lda); u.b = (const char*)(Bt + (size_t)pn * 256 * ldb);
        u.o = (size_t)pm * 256 * ldc + (size_t)pn * (MODE == 1 ? 128 : 256); u.ldc = ldc; u.row0 = pm * 256; return true;
    }
};
struct SchedInKV {
    const bf16_t* A; const bf16_t* Bt; const bf16_t* memn; const bf16_t* Wkv; int l, G, c;
    __device__ __forceinline__ bool next(int i, Unit& u) const {
        int pm, pn;
        if (std_tile(i, G, c, 128, 11, pm, pn)) { u.a = (const char*)(A + (size_t)pm * 256 * 1024); u.b = (const char*)(Bt + (size_t)pn * 256 * 1024);
            u.o = WS_H / 2 + (size_t)pm * 256 * DINP + (size_t)pn * 256; u.ldc = DINP; u.row0 = pm * 256; return true; }
        const long r = (long)i * G + c - 1408; if (r >= 64) return false;
        u.row0 = -1;
        if (r < 32) { const int b = (int)r >> 2, pn2 = (int)r & 3; u.a = (const char*)(memn + (size_t)b * 256 * 1024); u.b = (const char*)(Wkv + (size_t)pn2 * 256 * 1024);
            u.o = WS_K / 2 + ((size_t)l * 2048 + b * 256) * 1024 + pn2 * 256; u.ldc = 1024; }
        else { const int rr = (int)r - 32, pm2 = rr >> 3, b = rr & 7; u.a = (const char*)(Wkv + (size_t)(1024 + pm2 * 256) * 1024); u.b = (const char*)(memn + (size_t)b * 256 * 1024);
            u.o = WS_VT / 2 + (((size_t)l * 8 + b) * 1024 + pm2 * 256) * 256; u.ldc = 256; }
        return true;
    }
};
struct SchedKV {
    const bf16_t* memn; const bf16_t* W; size_t kbase, vbase; int G, c;
    __device__ __forceinline__ bool next(int i, Unit& u) const {
        const long L = (long)i * G + c; if (L >= 256) return false;
        const int l = (int)L >> 6, r = (int)L & 63; const bf16_t* wl = W + (size_t)l * WL_SZ + WXKV_O; const bf16_t* ml = memn + (size_t)l * 2048 * 1024;
        if (r < 32) { const int b = r >> 2, pn = r & 3; u.a = (const char*)(ml + (size_t)b * 256 * 1024); u.b = (const char*)(wl + (size_t)pn * 256 * 1024);
            u.o = kbase + ((size_t)l * 2048 + b * 256) * 1024 + pn * 256; u.ldc = 1024; u.row0 = 0; }
        else { const int rr = r - 32, pm = rr >> 3, b = rr & 7; u.a = (const char*)(wl + (size_t)(1024 + pm * 256) * 1024); u.b = (const char*)(ml + (size_t)b * 256 * 1024);
            u.o = vbase + (((size_t)l * 8 + b) * 1024 + pm * 256) * 256; u.ldc = 256; u.row0 = 0; }
        return true;
    }
};
template <int MODE> struct SchedAttn {
    const bf16_t* A; const bf16_t* Bm; int G, c;
    __device__ __forceinline__ bool next(int i, Unit& u) const {
        const long L = (long)i * G + c; if (L >= 512) return false;
        int pm = (int)L >> 2, h = (int)L & 3;
        if (G == 256) { pm = i * 64 + (c & 7) * 8 + (c >> 5); h = (c >> 3) & 3; }
        const int b = pm >> 4;
        u.a = (const char*)(A + (size_t)pm * 256 * 1024 + (MODE == 2 ? 0 : h * 256));
        u.b = MODE == 0 ? (const char*)(Bm + (size_t)b * 256 * 1024 + h * 256) : (MODE == 1 ? (const char*)(Bm + ((size_t)b * 1024 + h * 256) * 256) : (const char*)(Bm + (size_t)h * 256 * 1024));
        u.o = (size_t)pm * 256 * 1024 + h * 256; u.ldc = 1024; u.row0 = pm * 256; return true;
    }
};

struct EpiBf16 {
    static constexpr bool PERM = true, RSLDS = true; bf16_t* O; const float* rs = nullptr;
    __device__ __forceinline__ void operator()(const f32x4 (&acc)[2][2][4][2], const Unit& u, int wr, int wc, int fr, int fq, const LAS float* lrs) const {
        bf16_t* base = O + u.o + (size_t)(wr * 64 + fr) * u.ldc + wc * 32 + 8 * fq;
#pragma unroll
        for (int ai = 0; ai < 2; ++ai)
#pragma unroll
            for (int m = 0; m < 4; ++m) { bf16_t* rowp = base + (size_t)(ai * HALF + m * 16) * u.ldc; const float sc = (rs && u.row0 >= 0) ? lrs[ai * HALF + wr * 64 + m * 16 + fr] : 1.0f;
#pragma unroll
                for (int bj = 0; bj < 2; ++bj) { const f32x4 v0 = acc[ai][bj][m][0] * sc, v1 = acc[ai][bj][m][1] * sc;
                    u32x4 w; w.x = cvt_pk_bf16(v0[0], v0[1]); w.y = cvt_pk_bf16(v0[2], v0[3]); w.z = cvt_pk_bf16(v1[0], v1[1]); w.w = cvt_pk_bf16(v1[2], v1[3]);
                    *(u32x4*)(rowp + bj * HALF) = w; } }
    }
};
struct EpiSwiglu {
    static constexpr bool PERM = true, RSLDS = true; bf16_t* O; const float* rs;
    __device__ __forceinline__ void operator()(const f32x4 (&acc)[2][2][4][2], const Unit& u, int wr, int wc, int fr, int fq, const LAS float* lrs) const {
        bf16_t* base = O + u.o + (size_t)(wr * 64 + fr) * u.ldc + wc * 32 + 8 * fq;
#pragma unroll
        for (int ai = 0; ai < 2; ++ai)
#pragma unroll
            for (int m = 0; m < 4; ++m) { bf16_t* rowp = base + (size_t)(ai * HALF + m * 16) * u.ldc; const float sc = lrs[ai * HALF + wr * 64 + m * 16 + fr];
                float r[8];
#pragma unroll
                for (int n = 0; n < 2; ++n)
#pragma unroll
                    for (int e = 0; e < 4; ++e) r[n * 4 + e] = silu_f(acc[ai][0][m][n][e] * sc) * (acc[ai][1][m][n][e] * sc);
                u32x4 w; w.x = cvt_pk_bf16(r[0], r[1]); w.y = cvt_pk_bf16(r[2], r[3]); w.z = cvt_pk_bf16(r[4], r[5]); w.w = cvt_pk_bf16(r[6], r[7]);
                *(u32x4*)rowp = w; }
    }
};
struct EpiSoftmax {
    static constexpr bool PERM = true, RSLDS = false; bf16_t* O; float scale2; LAS float* st;
    __device__ __forceinline__ void operator()(f32x4 (&acc)[2][2][4][2], const Unit& u, int wr, int wc, int fr, int fq, const LAS float*) const {
#pragma unroll
        for (int ai = 0; ai < 2; ++ai)
#pragma unroll
            for (int m = 0; m < 4; ++m) { float mx = -3.0e38f;
#pragma unroll
                for (int bj = 0; bj < 2; ++bj)
#pragma unroll
                    for (int n = 0; n < 2; ++n)
#pragma unroll
                        for (int e = 0; e < 4; ++e) mx = fmaxf(mx, acc[ai][bj][m][n][e]);
                mx = fmaxf(mx, shx(mx, 16, fq * 16 + fr)); mx = fmaxf(mx, shx(mx, 32, fq * 16 + fr));
                if (fq == 0) st[(ai * HALF + wr * 64 + m * 16 + fr) * 4 + wc] = mx; }
        asm volatile("s_waitcnt lgkmcnt(0)" ::: "memory"); __builtin_amdgcn_s_barrier(); asm volatile("" ::: "memory");
#pragma unroll
        for (int ai = 0; ai < 2; ++ai)
#pragma unroll
            for (int m = 0; m < 4; ++m) { const int row = ai * HALF + wr * 64 + m * 16 + fr; const f32x4 m4 = *(const LAS f32x4*)(st + row * 4);
                const float mx = fmaxf(fmaxf(m4[0], m4[1]), fmaxf(m4[2], m4[3])); float sm = 0.f;
#pragma unroll
                for (int bj = 0; bj < 2; ++bj)
#pragma unroll
                    for (int n = 0; n < 2; ++n)
#pragma unroll
                        for (int e = 0; e < 4; ++e) { const float ex = __builtin_amdgcn_exp2f((acc[ai][bj][m][n][e] - mx) * scale2); acc[ai][bj][m][n][e] = ex; sm += ex; }
                sm += shx(sm, 16, fq * 16 + fr); sm += shx(sm, 32, fq * 16 + fr);
                if (fq == 0) st[1024 + row * 4 + wc] = sm; }
        asm volatile("s_waitcnt lgkmcnt(0)" ::: "memory"); __builtin_amdgcn_s_barrier(); asm volatile("" ::: "memory");
        bf16_t* base = O + u.o + (size_t)(wr * 64 + fr) * u.ldc + wc * 32 + 8 * fq;
#pragma unroll
        for (int ai = 0; ai < 2; ++ai)
#pragma unroll
            for (int m = 0; m < 4; ++m) { const int row = ai * HALF + wr * 64 + m * 16 + fr; const f32x4 s4 = *(const LAS f32x4*)(st + 1024 + row * 4);
                const float inv = 1.0f / ((s4[0] + s4[1]) + (s4[2] + s4[3])); bf16_t* rowp = base + (size_t)(ai * HALF + m * 16) * u.ldc;
#pragma unroll
                for (int bj = 0; bj < 2; ++bj) { const f32x4 v0 = acc[ai][bj][m][0] * inv, v1 = acc[ai][bj][m][1] * inv;
                    u32x4 w; w.x = cvt_pk_bf16(v0[0], v0[1]); w.y = cvt_pk_bf16(v0[2], v0[3]); w.z = cvt_pk_bf16(v1[0], v1[1]); w.w = cvt_pk_bf16(v1[2], v1[3]);
                    *(u32x4*)(rowp + bj * HALF) = w; } }
    }
};
struct EpiF32Scale {
    static constexpr bool PERM = false, RSLDS = false; float* O; float scale;
    __device__ __forceinline__ void operator()(const f32x4 (&acc)[2][2][4][2], const Unit& u, int wr, int wc, int fr, int fq, const LAS float*) const {
        float* base = O + u.o + (size_t)(wr * 64 + fr) * u.ldc + wc * 32 + 4 * fq;
#pragma unroll
        for (int ai = 0; ai < 2; ++ai)
#pragma unroll
            for (int m = 0; m < 4; ++m) { float* rowp = base + (size_t)(ai * HALF + m * 16) * u.ldc;
#pragma unroll
                for (int bj = 0; bj < 2; ++bj)
#pragma unroll
                    for (int n = 0; n < 2; ++n) *(f32x4*)(rowp + bj * HALF + n * 16) = acc[ai][bj][m][n] * scale; }
    }
};

template <int lda, int ldb, int K, class Epi, class Sched>
__device__ __forceinline__ void gemm_phase(LAS unsigned char* lds, const Sched& S, const Epi& E, const int wv) {
    const int tid = otid(wv), wid = __builtin_amdgcn_readfirstlane(tid >> 6), lane = tid & 63, wr = wid >> 2, wc = wid & 3, fr = lane & 15, fq = lane >> 4;
    const int nt = K / BK;
    unsigned voffA[2], voffB[2];
#pragma unroll
    for (int i = 0; i < 2; ++i) { int R, C; stage_rc(tid * 16 + i * 8192, R, C); const int Rb = Epi::PERM ? ((R & ~31) + perm32(R & 31)) : R;
        voffA[i] = (unsigned)(R * lda + C) * 2u; voffB[i] = (unsigned)(Rb * ldb + C) * 2u; }
    const size_t kstep = (size_t)(BK * 2);
    const size_t hstepA = (size_t)HALF * lda * 2, hstepB = (size_t)HALF * ldb * 2;
    const unsigned ldsw = (unsigned)wid * 1024u;
    const int aoff = lds_byte(wr * 64 + fr, fq * 8), boff = lds_byte(wc * 32 + fr, fq * 8);
#define PG8_SA(b, h) (((b) * 2 + (h)) * HTB)
#define PG8_SB(b, h) ((4 + (b) * 2 + (h)) * HTB)
#define PG8_STAGE(bufoff, gbase, voff) do { _Pragma("unroll") for (int _i = 0; _i < 2; ++_i) \
        __builtin_amdgcn_global_load_lds((const unsigned*)((const char*)(gbase) + (voff)[_i]), (LAS unsigned*)(lds + (bufoff) + ldsw + _i * 8192), 16, 0, 0); } while (0)
#define PG8_LDA(dst, b, h) do { _Pragma("unroll") for (int m = 0; m < 4; ++m) _Pragma("unroll") for (int k = 0; k < 2; ++k) dst[m][k] = *(const LAS bf16x8*)(lds + PG8_SA(b, h) + aoff + m * 2048 + k * 1024); } while (0)
#define PG8_LDB(dst, b, h) do { _Pragma("unroll") for (int n = 0; n < 2; ++n) _Pragma("unroll") for (int k = 0; k < 2; ++k) dst[n][k] = *(const LAS bf16x8*)(lds + PG8_SB(b, h) + boff + n * 2048 + k * 1024); } while (0)
#define PG8_MMA(ai, bj, At, Bt) do { __builtin_amdgcn_s_setprio(1); _Pragma("unroll") for (int m = 0; m < 4; ++m) _Pragma("unroll") for (int n = 0; n < 2; ++n) _Pragma("unroll") for (int k = 0; k < 2; ++k) \
        acc[ai][bj][m][n] = __builtin_amdgcn_mfma_f32_16x16x32_bf16(Bt[n][k], At[m][k], acc[ai][bj][m][n], 0, 0, 0); __builtin_amdgcn_s_setprio(0); } while (0)
#define PG8_WAIT_V(n) asm volatile("s_waitcnt vmcnt(" #n ")" ::: "memory")
#define PG8_WAIT_L(n) asm volatile("s_waitcnt lgkmcnt(" #n ")" ::: "memory")
#define PG8_BAR __builtin_amdgcn_s_barrier()
#define PG8_SCHED __builtin_amdgcn_sched_barrier(0)
    Unit cur, nxt; int ui = 0;
    if (!S.next(0, cur)) return;
    const char* cA = cur.a; const char* cB = cur.b;
    f32x4 acc[2][2][4][2];
#pragma unroll
    for (int a = 0; a < 2; ++a)
#pragma unroll
        for (int b = 0; b < 2; ++b)
#pragma unroll
            for (int m = 0; m < 4; ++m)
#pragma unroll
                for (int n = 0; n < 2; ++n) acc[a][b][m][n] = (f32x4){0.f, 0.f, 0.f, 0.f};
    bf16x8 At[4][2], B0[2][2], B1[2][2];
    PG8_STAGE(PG8_SB(0, 0), cB, voffB); PG8_STAGE(PG8_SB(0, 1), cB + hstepB, voffB); PG8_STAGE(PG8_SA(0, 0), cA, voffA); PG8_STAGE(PG8_SA(0, 1), cA + hstepA, voffA);
    if (wr == 1) PG8_BAR;
    PG8_WAIT_V(2); PG8_BAR;
    PG8_STAGE(PG8_SB(1, 0), cB + kstep, voffB); PG8_STAGE(PG8_SA(1, 0), cA + kstep, voffA); PG8_STAGE(PG8_SB(1, 1), cB + hstepB + kstep, voffB);
    PG8_WAIT_V(6); PG8_BAR;
    for (;;) {
        const bool has_next = S.next(ui + 1, nxt);
        const char* nA = has_next ? nxt.a : cA; const char* nB = has_next ? nxt.b : cB;
#pragma unroll 1
        for (int t = 0; t < nt; t += 2) {
            const bool last = (t == nt - 2);
            if constexpr (Epi::RSLDS) { if (t == 0 && wid < 4 && E.rs != nullptr && cur.row0 >= 0)
                __builtin_amdgcn_global_load_lds((const unsigned*)(E.rs + cur.row0 + wid * 64 + lane), (LAS unsigned*)(lds + STAGE_BYTES + (ui & 1) * 1024 + wid * 256), 4, 0, 0); }
            const char* a1 = cA + (size_t)(t + 1) * kstep;
            const char* a2 = last ? nA : cA + (size_t)(t + 2) * kstep; const char* b2 = last ? nB : cB + (size_t)(t + 2) * kstep;
            const char* a3 = a2 + kstep; const char* b3 = b2 + kstep;
            PG8_LDB(B0, 0, 0); PG8_LDB(B1, 0, 1); PG8_SCHED; PG8_LDA(At, 0, 0); PG8_STAGE(PG8_SA(1, 1), a1 + hstepA, voffA);
            PG8_WAIT_V(8); PG8_WAIT_L(0); PG8_BAR; PG8_MMA(0, 0, At, B0); PG8_MMA(0, 1, At, B1); PG8_BAR; PG8_SCHED;
            PG8_LDA(At, 0, 1); PG8_STAGE(PG8_SB(0, 0), b2, voffB); PG8_STAGE(PG8_SB(0, 1), b2 + hstepB, voffB); PG8_STAGE(PG8_SA(0, 0), a2, voffA);
            PG8_WAIT_V(8); PG8_WAIT_L(0); PG8_BAR; PG8_MMA(1, 0, At, B0); PG8_MMA(1, 1, At, B1); PG8_BAR; PG8_SCHED;
            PG8_LDB(B0, 1, 0); PG8_LDB(B1, 1, 1); PG8_SCHED; PG8_LDA(At, 1, 0); PG8_STAGE(PG8_SA(0, 1), a2 + hstepA, voffA);
            PG8_WAIT_V(8); PG8_WAIT_L(0); PG8_BAR; PG8_MMA(0, 0, At, B0); PG8_MMA(0, 1, At, B1); PG8_BAR; PG8_SCHED;
            PG8_LDA(At, 1, 1); PG8_STAGE(PG8_SB(1, 0), b3, voffB); PG8_STAGE(PG8_SB(1, 1), b3 + hstepB, voffB); PG8_STAGE(PG8_SA(1, 0), a3, voffA);
            PG8_WAIT_V(8); PG8_WAIT_L(0); PG8_BAR; PG8_MMA(1, 0, At, B0); PG8_MMA(1, 1, At, B1); PG8_BAR; PG8_SCHED;
        }
        if (wr == 0) PG8_BAR;
        { const int l2 = otid(wv) & 63; E(acc, cur, wr, wc, l2 & 15, l2 >> 4, (const LAS float*)(lds + STAGE_BYTES + (ui & 1) * 1024)); }
        if (!has_next) break;
#pragma unroll
        for (int a = 0; a < 2; ++a)
#pragma unroll
            for (int b = 0; b < 2; ++b)
#pragma unroll
                for (int m = 0; m < 4; ++m)
#pragma unroll
                    for (int n = 0; n < 2; ++n) acc[a][b][m][n] = (f32x4){0.f, 0.f, 0.f, 0.f};
        cur = nxt; cA = nA; cB = nB; ++ui;
        if (wr == 1) PG8_BAR;
    }
    PG8_WAIT_V(0);
    PG8_BAR;
#undef PG8_SA
#undef PG8_SB
#undef PG8_STAGE
#undef PG8_LDA
#undef PG8_LDB
#undef PG8_MMA
#undef PG8_WAIT_V
#undef PG8_WAIT_L
#undef PG8_BAR
#undef PG8_SCHED
}
}

struct ConvUnit { const float* src; bf16_t* dst; int Nsrc, k0, n0, ldd, drow0; const float* gk; };
__device__ __forceinline__ ConvUnit conv_decode(KP p, int t) {
    bf16_t* W = (bf16_t*)(p->ws + WS_W); const int l = t >> 10, r = t & 1023; bf16_t* wl = W + (size_t)l * WL_SZ; ConvUnit u;
    if (r < 176) { const int tn = r >> 2, kg = r & 3; u = ConvUnit{p->in[3] + (size_t)l * 1024 * DIN, wl + WIN_O, DIN, kg * 256, tn * 64, 1024, tn * 64, p->in[2] + (size_t)l * 1024}; }
    else if (r < 240) { const int q = r - 176, tn = q >> 2, kg = q & 3; u = ConvUnit{p->in[11] + (size_t)l * 1024 * 1024, wl + WOUT_O, 1024, kg * 256, tn * 64, 1024, tn * 64, nullptr}; }
    else if (r < 304) { const int q = r - 240, tn = q >> 2, kg = q & 3; u = ConvUnit{p->in[15] + (size_t)l * 1024 * 1024, wl + WXQ_O, 1024, kg * 256, tn * 64, 1024, tn * 64, p->in[13] + (size_t)l * 1024}; }
    else if (r < 432) { const int q = r - 304, tn = q >> 2, kg = q & 3; u = ConvUnit{p->in[16] + (size_t)l * 1024 * 2048, wl + WXKV_O, 2048, kg * 256, tn * 64, 1024, tn * 64, nullptr}; }
    else if (r < 496) { const int q = r - 432, tn = q >> 2, kg = q & 3; u = ConvUnit{p->in[17] + (size_t)l * 1024 * 1024, wl + WXO_O, 1024, kg * 256, tn * 64, 1024, tn * 64, nullptr}; }
    else if (r < 848) { const int q = r - 496, tn = q >> 2, kg = q & 3; const int n0 = tn * 64, isup = n0 >= DFF, j0 = isup ? n0 - DFF : n0;
        u = ConvUnit{p->in[20] + (size_t)l * 1024 * 2 * DFF, wl + WGU_O, 2 * DFF, kg * 256, n0, 1024, (j0 >> 7) * 256 + (isup ? 128 : 0) + (j0 & 127), p->in[19] + (size_t)l * 1024}; }
    else { const int q = r - 848, tn = q / 11, kg = q % 11; u = ConvUnit{p->in[21] + (size_t)l * DFF * 1024, wl + WDN_O, 1024, kg * 256, tn * 64, DFF, tn * 64, nullptr}; }
    return u;
}
__device__ __forceinline__ void conv_load(const ConvUnit& u, int tid, float4 (&v)[4][2]) {
#pragma unroll
    for (int i = 0; i < 4; ++i) { const int idx = tid + 512 * i, rp = idx >> 4, c4 = (idx & 15) * 4;
#pragma unroll
        for (int h = 0; h < 2; ++h) { const int r = 2 * rp + h; v[i][h] = make_float4(0.f, 0.f, 0.f, 0.f);
            if (u.n0 + c4 < u.Nsrc) { const f32x4 t4 = __builtin_nontemporal_load((const f32x4*)(u.src + (size_t)(u.k0 + r) * u.Nsrc + u.n0 + c4)); const float g = u.gk ? u.gk[u.k0 + r] : 1.0f;
                v[i][h] = make_float4(t4[0] * g, t4[1] * g, t4[2] * g, t4[3] * g); } } }
}
__device__ void phase_convert_weights(KP p, float* sT_, int wv) {
    unsigned* sT = (unsigned*)sT_;
    const int tid = otid(wv); int t = blockIdx.x; if (t >= DEPTH * 1024) return;
    ConvUnit u = conv_decode(p, t); float4 v[4][2]; conv_load(u, tid, v);
    for (;;) {
#pragma unroll
        for (int i = 0; i < 4; ++i) { const int idx = tid + 512 * i, rp = idx >> 4, c4 = (idx & 15) * 4;
            sT[(c4 + 0) * 129 + rp] = cvt_pk_bf16(v[i][0].x, v[i][1].x); sT[(c4 + 1) * 129 + rp] = cvt_pk_bf16(v[i][0].y, v[i][1].y);
            sT[(c4 + 2) * 129 + rp] = cvt_pk_bf16(v[i][0].z, v[i][1].z); sT[(c4 + 3) * 129 + rp] = cvt_pk_bf16(v[i][0].w, v[i][1].w); }
        __syncthreads();
        const ConvUnit cu = u; const int tn = t + gridDim.x; const bool more = tn < DEPTH * 1024;
        if (more) { u = conv_decode(p, tn); conv_load(u, tid, v); }
#pragma unroll
        for (int i = 0; i < 4; ++i) { const int q = tid + 512 * i, nl = q & 63, kc = q >> 6;
            u32x4 w; w.x = sT[nl * 129 + kc * 4]; w.y = sT[nl * 129 + kc * 4 + 1]; w.z = sT[nl * 129 + kc * 4 + 2]; w.w = sT[nl * 129 + kc * 4 + 3];
            *(u32x4*)(cu.dst + (size_t)(cu.drow0 + nl) * cu.ldd + cu.k0 + kc * 8) = w; }
        __syncthreads();
        if (!more) break;
        t = tn;
    }
}
__device__ void rms_rows_bf16(const float* src, const float* g, bf16_t* dst, int nrows, int wv) {
    const int lane = otid(wv) & 63, gw = blockIdx.x * 8 + (otid(wv) >> 6), nw = gridDim.x * 8;
    for (int row0 = gw * 4; row0 < nrows; row0 += nw * 4) {
        float4 v[4][4];
#pragma unroll
        for (int r = 0; r < 4; ++r)
#pragma unroll
            for (int i = 0; i < 4; ++i) v[r][i] = ((const float4*)(src + (size_t)(row0 + r) * 1024))[i * 64 + lane];
#pragma unroll
        for (int r = 0; r < 4; ++r) { float ss = 0.f;
#pragma unroll
            for (int i = 0; i < 4; ++i) ss += v[r][i].x * v[r][i].x + v[r][i].y * v[r][i].y + v[r][i].z * v[r][i].z + v[r][i].w * v[r][i].w;
            ss = wave_sum(ss, lane); const float rs = rsqrtf(ss * (1.0f / 1024.0f) + EPS);
#pragma unroll
            for (int i = 0; i < 4; ++i) { const float4 gg = ((const float4*)g)[i * 64 + lane];
                u32x2 w; w.x = cvt_pk_bf16(v[r][i].x * rs * gg.x, v[r][i].y * rs * gg.y); w.y = cvt_pk_bf16(v[r][i].z * rs * gg.z, v[r][i].w * rs * gg.w);
                *(u32x2*)(dst + (size_t)(row0 + r) * 1024 + i * 256 + lane * 4) = w; } }
    }
}
__device__ void phase_x_init(const float* src, bf16_t* dst, float* rsout, int wv) {
    const int lane = otid(wv) & 63, gw = blockIdx.x * 8 + (otid(wv) >> 6), nw = gridDim.x * 8;
    for (int row0 = gw * 4; row0 < MTOK; row0 += nw * 4) {
        float4 v[4][4];
#pragma unroll
        for (int r = 0; r < 4; ++r)
#pragma unroll
            for (int i = 0; i < 4; ++i) v[r][i] = ((const float4*)(src + (size_t)(row0 + r) * 1024))[i * 64 + lane];
#pragma unroll
        for (int r = 0; r < 4; ++r) { float ss = 0.f;
#pragma unroll
            for (int i = 0; i < 4; ++i) { ss += v[r][i].x * v[r][i].x + v[r][i].y * v[r][i].y + v[r][i].z * v[r][i].z + v[r][i].w * v[r][i].w;
                u32x2 w; w.x = cvt_pk_bf16(v[r][i].x, v[r][i].y); w.y = cvt_pk_bf16(v[r][i].z, v[r][i].w);
                *(u32x2*)(dst + (size_t)(row0 + r) * 1024 + i * 256 + lane * 4) = w; }
            ss = wave_sum(ss, lane); if (lane == 0) rsout[row0 + r] = rsqrtf(ss * (1.0f / 1024.0f) + EPS); }
    }
}
template <bool XIN_BF, bool XOUT_BF>
__device__ void phase_norm_res(const bf16_t* y, const void* xin_, void* xout_, const float* gpost, float* rsout, int wv) {
    const int lane = otid(wv) & 63, gw = blockIdx.x * 8 + (otid(wv) >> 6), nw = gridDim.x * 8;
    for (int row0 = gw * 4; row0 < MTOK; row0 += nw * 4) {
        u32x2 yw[4][4]; float4 xv[4][4];
#pragma unroll
        for (int r = 0; r < 4; ++r)
#pragma unroll
            for (int i = 0; i < 4; ++i) { yw[r][i] = *(const u32x2*)(y + (size_t)(row0 + r) * 1024 + i * 256 + lane * 4);
                if (XIN_BF) { const u32x2 w = *(const u32x2*)((const bf16_t*)xin_ + (size_t)(row0 + r) * 1024 + i * 256 + lane * 4); xv[r][i] = make_float4(bf_lo(w.x), bf_hi(w.x), bf_lo(w.y), bf_hi(w.y)); }
                else xv[r][i] = ((const float4*)((const float*)xin_ + (size_t)(row0 + r) * 1024))[i * 64 + lane]; }
#pragma unroll
        for (int r = 0; r < 4; ++r) { float ss = 0.f; float yv[4][4];
#pragma unroll
            for (int i = 0; i < 4; ++i) { yv[i][0] = bf_lo(yw[r][i].x); yv[i][1] = bf_hi(yw[r][i].x); yv[i][2] = bf_lo(yw[r][i].y); yv[i][3] = bf_hi(yw[r][i].y);
#pragma unroll
                for (int e = 0; e < 4; ++e) ss += yv[i][e] * yv[i][e]; }
            ss = wave_sum(ss, lane); const float rs = rsqrtf(ss * (1.0f / 1024.0f) + EPS); float s2 = 0.f;
#pragma unroll
            for (int i = 0; i < 4; ++i) { const float4 gg = ((const float4*)gpost)[i * 64 + lane]; float4& x = xv[r][i];
                x.x += yv[i][0] * rs * gg.x; x.y += yv[i][1] * rs * gg.y; x.z += yv[i][2] * rs * gg.z; x.w += yv[i][3] * rs * gg.w;
                s2 += x.x * x.x + x.y * x.y + x.z * x.z + x.w * x.w;
                if (XOUT_BF) { u32x2 w; w.x = cvt_pk_bf16(x.x, x.y); w.y = cvt_pk_bf16(x.z, x.w); *(u32x2*)((bf16_t*)xout_ + (size_t)(row0 + r) * 1024 + i * 256 + lane * 4) = w; }
                else ((float4*)((float*)xout_ + (size_t)(row0 + r) * 1024))[i * 64 + lane] = x; }
            if (rsout) { s2 = wave_sum(s2, lane); if (lane == 0) rsout[row0 + r] = rsqrtf(s2 * (1.0f / 1024.0f) + EPS); } }
    }
}
__device__ __forceinline__ bf16x8 pack8(const float (&f)[8]) { u32x4 w; w.x = cvt_pk_bf16(f[0], f[1]); w.y = cvt_pk_bf16(f[2], f[3]); w.z = cvt_pk_bf16(f[4], f[5]); w.w = cvt_pk_bf16(f[6], f[7]); return __builtin_bit_cast(bf16x8, w); }
__device__ __forceinline__ void unpack8(const u32x4 w, float (&f)[8]) { f[0] = bf_lo(w.x); f[1] = bf_hi(w.x); f[2] = bf_lo(w.y); f[3] = bf_hi(w.y); f[4] = bf_lo(w.z); f[5] = bf_hi(w.z); f[6] = bf_lo(w.w); f[7] = bf_hi(w.w); }

__device__ void phase_gla_chunk(KP p, int l, LAS unsigned char* lds, int wv) {
    asm volatile("" : "+s"(p));
    const bf16_t* H = (const bf16_t*)(p->ws + WS_H); bf16_t* UB = (bf16_t*)(p->ws + WS_Y); float* AC = (float*)(p->ws + WS_AC);
    const float* wg = p->in[4] + (size_t)l * 16 * 256; const float* bg = p->in[5] + (size_t)l * 256;
    const int tid = otid(wv), lane = tid & 63, fr = lane & 15, fq = lane >> 4, c = tid & 63, seg = tid >> 6;
    int u = blockIdx.x; if (u >= 2048) return;
    u32x4 aw = (u32x4){0u, 0u, 0u, 0u}; u32x4 vw[2]; bf16_t kn[8];
#define GC_LOAD(uu) do { const int hd_ = (uu) & 3, n_ = ((uu) >> 2) & 63, b_ = (uu) >> 8; const size_t t0_ = (size_t)b_ * SEQ + n_ * 64; \
        if (tid < 128) aw = *(const u32x4*)(H + (t0_ + (tid >> 1)) * DINP + OFF_A + (tid & 1) * 8); \
        _Pragma("unroll") for (int i = 0; i < 2; ++i) { const int idx = tid + 512 * i; vw[i] = *(const u32x4*)(H + (t0_ + (idx & 63)) * DINP + OFF_V + hd_ * 128 + (idx >> 6) * 8); } \
        _Pragma("unroll") for (int i = 0; i < 8; ++i) kn[i] = H[(t0_ + seg * 8 + i) * DINP + OFF_K + hd_ * 64 + c]; } while (0)
    GC_LOAD(u);
    int hd_prev = -1; float wr_[16]; float bgc = 0.f;
#pragma unroll
    for (int r = 0; r < 16; ++r) wr_[r] = 0.f;
    for (int it = 0;; ++it) {
        LAS float* sA = (LAS float*)(lds + (it & 1) * 33792); LAS float* sTot = sA + 1024; LAS bf16_t* kdT = (LAS bf16_t*)(sTot + 512); LAS bf16_t* vT = kdT + 64 * 72;
        const int hd = u & 3;
        if (hd != hd_prev) { hd_prev = hd; bgc = bg[hd * 64 + c];
#pragma unroll
            for (int r = 0; r < 16; ++r) wr_[r] = wg[r * 256 + hd * 64 + c]; }
        if (tid < 128) { float f[8]; unpack8(aw, f); LAS float* d = sA + (tid >> 1) * 16 + (tid & 1) * 8; *(LAS f32x4*)d = (f32x4){f[0], f[1], f[2], f[3]}; *(LAS f32x4*)(d + 4) = (f32x4){f[4], f[5], f[6], f[7]}; }
#pragma unroll
        for (int i = 0; i < 2; ++i) { const int idx = tid + 512 * i, tok = idx & 63, c8 = (idx >> 6) * 8; const unsigned ww[4] = {vw[i].x, vw[i].y, vw[i].z, vw[i].w};
#pragma unroll
            for (int j = 0; j < 8; ++j) vT[(c8 + j) * 72 + tok] = (bf16_t)((j & 1) ? (ww[j >> 1] >> 16) : (ww[j >> 1] & 0xffffu)); }
        float kk[8];
#pragma unroll
        for (int i = 0; i < 8; ++i) kk[i] = bf2f(kn[i]);
        __syncthreads();
        const int un = u + gridDim.x; const bool more = un < 2048;
        if (more) GC_LOAD(un);
        float cl[8]; float run = 0.f;
#pragma unroll
        for (int i = 0; i < 8; ++i) { const LAS float* a = sA + (seg * 8 + i) * 16; float z = bgc;
#pragma unroll
            for (int r = 0; r < 16; ++r) z += a[r] * wr_[r];
            run += logsigmoid_f(z) * (1.0f / 16.0f); cl[i] = run; }
        sTot[seg * 64 + c] = run;
        __syncthreads();
        float pre = 0.f, tot = 0.f;
#pragma unroll
        for (int s = 0; s < 8; ++s) { const float v = sTot[s * 64 + c]; tot += v; if (s < seg) pre += v; }
        { float kd[8];
#pragma unroll
            for (int i = 0; i < 8; ++i) kd[i] = kk[i] * __expf(tot - (pre + cl[i]));
            *(LAS bf16x8*)(kdT + c * 72 + seg * 8) = pack8(kd); }
        if (seg == 0) AC[(size_t)u * 64 + c] = __expf(tot);
        __syncthreads();
        { bf16x8 bv[2];
#pragma unroll
            for (int ks = 0; ks < 2; ++ks) bv[ks] = *(const LAS bf16x8*)(vT + (wv * 16 + fr) * 72 + (ks * 4 + fq) * 8);
            bf16_t* ub = UB + (size_t)u * 8192 + (wv * 16 + fr) * 64 + fq * 4;
#pragma unroll
            for (int mt = 0; mt < 4; ++mt) { f32x4 acc = (f32x4){0.f, 0.f, 0.f, 0.f};
#pragma unroll
                for (int ks = 0; ks < 2; ++ks) { const bf16x8 av = *(const LAS bf16x8*)(kdT + (mt * 16 + fr) * 72 + (ks * 4 + fq) * 8);
                    acc = __builtin_amdgcn_mfma_f32_16x16x32_bf16(av, bv[ks], acc, 0, 0, 0); }
                u32x2 w; w.x = cvt_pk_bf16(acc[0], acc[1]); w.y = cvt_pk_bf16(acc[2], acc[3]); *(u32x2*)(ub + mt * 16) = w; } }
        if (!more) break;
        u = un;
    }
#undef GC_LOAD
    __syncthreads();
}
__device__ void phase_gla_scan(KP p, int wv) {
    asm volatile("" : "+s"(p));
    unsigned* UB = (unsigned*)(p->ws + WS_Y); const float* AC = (const float*)(p->ws + WS_AC);
    for (int e = blockIdx.x * 512 + otid(wv); e < 131072; e += gridDim.x * 512) {
        const int k2 = e & 31, v = (e >> 5) & 127, hd = (e >> 12) & 3, b = e >> 14;
        unsigned* ub = UB + (((size_t)b * 256 + hd) * 8192 + v * 64 + k2 * 2) / 2; const float* ab = AC + ((size_t)b * 256 + hd) * 64 + k2 * 2;
        float2 s = make_float2(0.f, 0.f);
        for (int n0 = 0; n0 < 64; n0 += 32) { unsigned uu[32]; float2 aa[32];
#pragma unroll
            for (int j = 0; j < 32; ++j) { uu[j] = ub[(size_t)(n0 + j) * 16384]; aa[j] = *(const float2*)(ab + (n0 + j) * 256); }
#pragma unroll
            for (int j = 0; j < 32; ++j) { s.x = aa[j].x * s.x + bf_lo(uu[j]); s.y = aa[j].y * s.y + bf_hi(uu[j]); ub[(size_t)(n0 + j) * 16384] = cvt_pk_bf16(s.x, s.y); } }
    }
}
__device__ void phase_gla_out(KP p, int l, LAS unsigned char* lds, int wv) {
    asm volatile("" : "+s"(p));
    LAS float* sO0 = (LAS float*)lds;
    const bf16_t* H = (const bf16_t*)(p->ws + WS_H); const bf16_t* UB = (const bf16_t*)(p->ws + WS_Y); bf16_t* MIX = (bf16_t*)(p->ws + WS_XN);
    const float* onorm = p->in[6] + (size_t)l * 512; const int tid = otid(wv), lane = tid & 63, fr = lane & 15, fq = lane >> 4;
    const int tt = tid >> 3, v0 = (tid & 7) * 16;
    int u = blockIdx.x; if (u >= 2048) return;
    bf16x8 bsn[2]; bf16x8 av[4][2]; u32x4 gw[2];
#define GO_LOAD(uu) do { const int hd_ = (uu) & 3, n_ = ((uu) >> 2) & 63, b_ = (uu) >> 8; const size_t t0_ = (size_t)b_ * SEQ + n_ * 64; \
        _Pragma("unroll") for (int ks = 0; ks < 2; ++ks) bsn[ks] = *(const bf16x8*)(UB + (size_t)(uu) * 8192 + (wv * 16 + fr) * 64 + ks * 32 + fq * 8); \
        _Pragma("unroll") for (int mt = 0; mt < 4; ++mt) _Pragma("unroll") for (int ks = 0; ks < 2; ++ks) av[mt][ks] = *(const bf16x8*)(H + (t0_ + mt * 16 + fr) * DINP + OFF_Q + hd_ * 64 + ks * 32 + fq * 8); \
        _Pragma("unroll") for (int h8 = 0; h8 < 2; ++h8) gw[h8] = *(const u32x4*)(H + (t0_ + tt) * DINP + OFF_G + hd_ * 128 + v0 + h8 * 8); } while (0)
    GO_LOAD(u);
    for (int it = 0;; ++it) {
        LAS float* sO = sO0 + (it & 1) * (64 * 132);
        const int hd = u & 3, n = (u >> 2) & 63, b = u >> 8; const size_t t0 = (size_t)b * SEQ + n * 64;
        const bf16x8 bs[2] = {bsn[0], bsn[1]};
#pragma unroll
        for (int mt = 0; mt < 4; ++mt) { f32x4 acc = (f32x4){0.f, 0.f, 0.f, 0.f};
#pragma unroll
            for (int ks = 0; ks < 2; ++ks) acc = __builtin_amdgcn_mfma_f32_16x16x32_bf16(av[mt][ks], bs[ks], acc, 0, 0, 0);
#pragma unroll
            for (int e = 0; e < 4; ++e) sO[(mt * 16 + fq * 4 + e) * 132 + wv * 16 + fr] = acc[e] * 0.125f; }
        float g[2][8]; unpack8(gw[0], g[0]); unpack8(gw[1], g[1]);
        __syncthreads();
        const int un = u + gridDim.x; const bool more = un < 2048;
        if (more) GO_LOAD(un);
        { f32x4 o[4]; float ss = 0.f;
#pragma unroll
            for (int q = 0; q < 4; ++q) { o[q] = *(const LAS f32x4*)(sO + tt * 132 + v0 + q * 4); ss += o[q][0] * o[q][0] + o[q][1] * o[q][1] + o[q][2] * o[q][2] + o[q][3] * o[q][3]; }
            ss = row8_sum(ss);
            const float rs = rsqrtf(ss * (1.0f / 128.0f) + EPS); bf16_t* op = MIX + (t0 + tt) * 1024 + hd * 128 + v0;
#pragma unroll
            for (int h8 = 0; h8 < 2; ++h8) { const float4 n0 = *(const float4*)(onorm + hd * 128 + v0 + h8 * 8), n1 = *(const float4*)(onorm + hd * 128 + v0 + h8 * 8 + 4);
                const f32x4 o0 = o[h8 * 2], o1 = o[h8 * 2 + 1];
                const float r[8] = {o0[0] * rs * n0.x * silu_f(g[h8][0]), o0[1] * rs * n0.y * silu_f(g[h8][1]), o0[2] * rs * n0.z * silu_f(g[h8][2]), o0[3] * rs * n0.w * silu_f(g[h8][3]),
                                    o1[0] * rs * n1.x * silu_f(g[h8][4]), o1[1] * rs * n1.y * silu_f(g[h8][5]), o1[2] * rs * n1.z * silu_f(g[h8][6]), o1[3] * rs * n1.w * silu_f(g[h8][7])};
                *(bf16x8*)(op + h8 * 8) = pack8(r); } }
        if (!more) break;
        u = un;
    }
#undef GO_LOAD
    __syncthreads();
}
__device__ void phase_sg(KP p, int l, LAS unsigned char* lds, int wv) {
    asm volatile("" : "+s"(p));
    LAS float* sStat = (LAS float*)lds; LAS bf16_t* svT0 = (LAS bf16_t*)(lds + 1024);
    const bf16_t* H = (const bf16_t*)(p->ws + WS_H); bf16_t* MIX = (bf16_t*)(p->ws + WS_XN); const bf16_t* WSB = (const bf16_t*)(p->ws + WS_AC + 524288) + (size_t)l * 4 * 128 * 128;
    const float* lng = p->in[7] + (size_t)l * 512; const float* lnb = p->in[8] + (size_t)l * 512; const float* bsp = p->in[10] + (size_t)l * 4 * 128;
    const int tid = otid(wv), lane = tid & 63, fr = lane & 15, fq = lane >> 4;
    for (int u = blockIdx.x; u < 256; u += gridDim.x) {
        const size_t t0 = (size_t)u * 128;
        for (int tb = 0; tb < 16; tb += 8) { u32x4 w8[8];
#pragma unroll
            for (int j = 0; j < 8; ++j) w8[j] = *(const u32x4*)(H + (t0 + wv * 16 + tb + j) * DINP + OFF_SV + lane * 8);
            float s1[8], s2[8];
#pragma unroll
            for (int j = 0; j < 8; ++j) { float f[8]; unpack8(w8[j], f); s1[j] = 0.f; s2[j] = 0.f;
#pragma unroll
                for (int e = 0; e < 8; ++e) { const float x = gelu_tanh(f[e]); s1[j] += x; s2[j] += x * x; } }
#pragma unroll
            for (int j = 0; j < 8; ++j) { s1[j] = wave_sum(s1[j], lane); s2[j] = wave_sum(s2[j], lane); }
            if (lane < 8) { float m1 = s1[0], m2 = s2[0];
#pragma unroll
                for (int j = 1; j < 8; ++j) if (lane == j) { m1 = s1[j]; m2 = s2[j]; }
                const float mu = m1 * (1.0f / 512.0f), var = fmaxf(m2 * (1.0f / 512.0f) - mu * mu, 0.f);
                sStat[(wv * 16 + tb + lane) * 2] = mu; sStat[(wv * 16 + tb + lane) * 2 + 1] = rsqrtf(var + EPS); } }
        __syncthreads();
        u32x4 svw[4];
#pragma unroll
        for (int it = 0; it < 4; ++it) { const int idx = tid + 512 * it, j = idx & 127, c8 = (idx >> 7) * 8; svw[it] = *(const u32x4*)(H + (t0 + j) * DINP + OFF_SV + c8); }
        for (int g = 0; g < 4; ++g) {
            LAS bf16_t* svT = svT0 + (g & 1) * (128 * 136);
            const int i = wv * 16 + fr; const size_t tok = t0 + i;
            bf16x8 wb[4]; u32x2 uw[8];
#pragma unroll
            for (int ks = 0; ks < 4; ++ks) wb[ks] = *(const bf16x8*)(WSB + ((size_t)g * 128 + i) * 128 + ks * 32 + fq * 8);
#pragma unroll
            for (int mt = 0; mt < 8; ++mt) uw[mt] = *(const u32x2*)(H + tok * DINP + OFF_U + g * 128 + mt * 16 + fq * 4);
            const float bs = bsp[g * 128 + i];
#pragma unroll
            for (int it = 0; it < 4; ++it) { const int idx = tid + 512 * it, j = idx & 127, c8 = (idx >> 7) * 8; float f[8];
                unpack8(svw[it], f);
                const float mu = sStat[j * 2], rs = sStat[j * 2 + 1];
#pragma unroll
                for (int e = 0; e < 8; ++e) { const float o = (gelu_tanh(f[e]) - mu) * rs * lng[g * 128 + c8 + e] + lnb[g * 128 + c8 + e];
                    svT[(c8 + e) * 136 + j] = (bf16_t)(cvt_pk_bf16(o, 0.f) & 0xffffu); } }
            __syncthreads();
            if (g < 3) {
#pragma unroll
                for (int it = 0; it < 4; ++it) { const int idx = tid + 512 * it, j = idx & 127, c8 = (idx >> 7) * 8; svw[it] = *(const u32x4*)(H + (t0 + j) * DINP + OFF_SV + (g + 1) * 128 + c8); } }
            f32x4 acc[8];
#pragma unroll
            for (int mt = 0; mt < 8; ++mt) { acc[mt] = (f32x4){0.f, 0.f, 0.f, 0.f};
#pragma unroll
                for (int ks = 0; ks < 4; ++ks) if (ks < 2 || wv >= 4) {
                    const bf16x8 av = *(const LAS bf16x8*)(svT + (mt * 16 + fr) * 136 + ks * 32 + fq * 8);
                    acc[mt] = __builtin_amdgcn_mfma_f32_16x16x32_bf16(av, wb[ks], acc[mt], 0, 0, 0); } }
#pragma unroll
            for (int mt = 0; mt < 8; ++mt) { const int cc = g * 128 + mt * 16 + fq * 4;
                const float r0 = gelu_tanh(bf_lo(uw[mt].x)) * (acc[mt][0] + bs), r1 = gelu_tanh(bf_hi(uw[mt].x)) * (acc[mt][1] + bs);
                const float r2 = gelu_tanh(bf_lo(uw[mt].y)) * (acc[mt][2] + bs), r3 = gelu_tanh(bf_hi(uw[mt].y)) * (acc[mt][3] + bs);
                u32x2 w; w.x = cvt_pk_bf16(r0, r1); w.y = cvt_pk_bf16(r2, r3);
                *(u32x2*)(MIX + tok * 1024 + 512 + cc) = w; }
        }
        __syncthreads();
    }
}
__device__ void phase_convert_wsp(KP p, int wv) {
    asm volatile("" : "+s"(p));
    const float4* src = (const float4*)p->in[9]; u32x2* dst = (u32x2*)(p->ws + WS_AC + 524288);
    for (int i = blockIdx.x * 512 + otid(wv); i < DEPTH * 4 * 128 * 128 / 4; i += gridDim.x * 512) { const float4 v = src[i]; u32x2 w; w.x = cvt_pk_bf16(v.x, v.y); w.y = cvt_pk_bf16(v.z, v.w); dst[i] = w; }
}

#define XB_TMO      128
#define XB_XCNT(j)  (256  + 64 * (j))
#define XB_XSUB(j)  (1280 + 64 * (j))
#define XB_XGEN(j)  (2304 + 64 * (j))
#define XB_TOP      3328
#define XB_TOPGEN   3392
#define XCD_BAR_WORDS 3456
#define XB_SPIN_CAP (1u << 22)
__device__ __forceinline__ unsigned xb_ld(unsigned* p)              { return __hip_atomic_load(p, __ATOMIC_RELAXED, __HIP_MEMORY_SCOPE_AGENT); }
__device__ __forceinline__ unsigned xb_add(unsigned* p, unsigned v) { return __hip_atomic_fetch_add(p, v, __ATOMIC_RELAXED, __HIP_MEMORY_SCOPE_AGENT); }
__device__ __forceinline__ unsigned xb_xcc_id() { return (unsigned)__builtin_amdgcn_s_getreg((3 << 11) | 20) & 0xFu; }
#define XB_SPIN(cond, bar) do { unsigned _sp = 0; while (cond) { __builtin_amdgcn_s_sleep(1); \
    if ((++_sp & 255u) == 0u) { if (xb_ld(&(bar)[XB_TMO])) break; if (_sp > XB_SPIN_CAP) { atomicAdd(&(bar)[XB_TMO], 1u); break; } } } } while (0)
struct XcdBarrier { unsigned* bar; unsigned x; volatile LAS unsigned* st; };
__device__ __forceinline__ XcdBarrier xcd_barrier_post(unsigned* bar, volatile LAS unsigned* st) {
    XcdBarrier b; b.bar = bar; b.x = xb_xcc_id(); b.st = st;
    if (threadIdx.x == 0) (void)xb_add(&bar[XB_XCNT(b.x)], 1u);
    return b;
}
__device__ __forceinline__ void xcd_barrier_complete(unsigned* bar, unsigned x, unsigned& nloc, unsigned& nx) {
    const unsigned G = gridDim.x * gridDim.y * gridDim.z;
    unsigned sum, cnt, mine, sp = 0u;
    for (;;) {
        sum = 0u; cnt = 0u; mine = 0u;
#pragma unroll
        for (unsigned j = 0; j < 16; ++j) { const unsigned c = xb_ld(&bar[XB_XCNT(j)]); sum += c; cnt += (c > 0u) ? 1u : 0u; mine = (j == x) ? c : mine; }
        if (sum == G) break;
        __builtin_amdgcn_s_sleep(1);
        if ((++sp & 255u) == 0u) { if (xb_ld(&bar[XB_TMO])) break; if (sp > XB_SPIN_CAP) { atomicAdd(&bar[XB_TMO], 1u); break; } }
    }
    nloc = mine > 0u ? mine : 1u; nx = cnt > 0u ? cnt : 1u;
}
__device__ __forceinline__ void xcd_barrier(const XcdBarrier& b, const int tid) {
    asm volatile("s_waitcnt vmcnt(0)" ::: "memory");
    __syncthreads();
    if (tid == 0) {
        unsigned* bar = b.bar;
        __builtin_amdgcn_s_waitcnt(0);
        unsigned nloc = b.st[0], nx = b.st[1];
        if (nloc == 0u) { xcd_barrier_complete(bar, b.x, nloc, nx); b.st[0] = nloc; b.st[1] = nx; }
        const unsigned old = xb_add(&bar[XB_XSUB(b.x)], 1u);
        const unsigned gen = old / nloc;
        if (old + 1u == (gen + 1u) * nloc) {
            __builtin_amdgcn_fence(__ATOMIC_RELEASE, "agent");
            asm volatile("s_waitcnt vmcnt(0)" ::: "memory");
            const unsigned og = xb_add(&bar[XB_TOP], 1u);
            const unsigned tg = og / nx;
            if (og + 1u == (tg + 1u) * nx) xb_add(&bar[XB_TOPGEN], 1u);
            else XB_SPIN(xb_ld(&bar[XB_TOPGEN]) == tg, bar);
            __builtin_amdgcn_fence(__ATOMIC_ACQUIRE, "agent");
            xb_add(&bar[XB_XGEN(b.x)], 1u);
            asm volatile("s_waitcnt vmcnt(0)" ::: "memory");
        } else {
            XB_SPIN(xb_ld(&bar[XB_XGEN(b.x)]) == gen, bar);
            __builtin_amdgcn_fence(__ATOMIC_ACQUIRE, "agent");
            asm volatile("s_waitcnt vmcnt(0)" ::: "memory");
        }
    }
    __syncthreads();
}

__global__ void __launch_bounds__(512) fwd_megakernel(Params p_unused) {
    KP p = (KP)__builtin_amdgcn_kernarg_segment_ptr();
    extern __shared__ __attribute__((aligned(16))) unsigned char shm[];
    cg::grid_group grid = cg::this_grid();
    LAS unsigned char* lds = (LAS unsigned char*)shm; float* smf = (float*)shm;
    const int G = gridDim.x, c = blockIdx.x;
    volatile LAS unsigned* xbw = (volatile LAS unsigned*)(lds + LDS_MAIN);
    if (threadIdx.x < 4) xbw[threadIdx.x] = 0u;
    __syncthreads();
    const XcdBarrier xbar = xcd_barrier_post((unsigned*)(fresh(p)->ws + WS_BAR), xbw);
const int wv = __builtin_amdgcn_readfirstlane(threadIdx.x >> 6);
#define GSYNC() do { xcd_barrier(xbar, otid(wv)); if (PROBE & 16) xcd_barrier(xbar, otid(wv)); } while (0)
    bf16_t* W = (bf16_t*)(fresh(p)->ws + WS_W); bf16_t* KB = (bf16_t*)(fresh(p)->ws + WS_K); bf16_t* VT = (bf16_t*)(fresh(p)->ws + WS_VT);
    bf16_t* XN = (bf16_t*)(fresh(p)->ws + WS_XN); bf16_t* Hb = (bf16_t*)(fresh(p)->ws + WS_H); bf16_t* Yb = (bf16_t*)(fresh(p)->ws + WS_Y);
    bf16_t* MEMN = (bf16_t*)(fresh(p)->ws + WS_MEMN);
    float* RS = (float*)(fresh(p)->ws + WS_BAR + 65536);

    for (int rep = 0; rep < ((PROBE & 4) ? 2 : 1); ++rep) phase_convert_weights(fresh(p), smf, wv);
    phase_convert_wsp(fresh(p), wv);
    phase_x_init(fresh(p)->in[0], (bf16_t*)fresh(p)->out, RS, wv);
    for (int l = 0; l < DEPTH; ++l) rms_rows_bf16(fresh(p)->in[1], fresh(p)->in[14] + (size_t)l * 1024, MEMN + (size_t)l * 2048 * 1024, BATCH * NMEM, wv);
    GSYNC();
    if (fresh(p)->ws == nullptr) grid.sync();

    for (int l = 0; l < DEPTH; ++l) {
        const bf16_t* wl = W + (size_t)l * WL_SZ;
        for (int rep = 0; rep < ((PROBE & 1) ? 2 : 1); ++rep) { pg8::SchedInKV S{(const bf16_t*)fresh(p)->out, wl + WIN_O, MEMN + (size_t)l * 2048 * 1024, wl + WXKV_O, l, G, c}; pg8::EpiBf16 E{(bf16_t*)fresh(p)->ws, RS}; pg8::gemm_phase<1024, 1024, 1024>(lds, S, E, wv); }
        GSYNC();
        for (int rep = 0; rep < ((PROBE & 2) ? 2 : 1); ++rep) phase_gla_chunk(fresh(p), l, lds, wv);
        GSYNC();
        for (int step = 0; step < 2; ++step) { if ((step ^ ((c >> 3) & 1)) == 0) phase_gla_scan(fresh(p), wv); else phase_sg(fresh(p), l, lds, wv); }
        GSYNC();
        for (int rep = 0; rep < ((PROBE & 2) ? 2 : 1); ++rep) phase_gla_out(fresh(p), l, lds, wv);
        GSYNC();
        for (int rep = 0; rep < ((PROBE & 1) ? 2 : 1); ++rep) { pg8::SchedStd<0> S{XN, wl + WOUT_O, 128, 4, 1024, 1024, 1024, G, c}; pg8::EpiBf16 E{Yb}; pg8::gemm_phase<1024, 1024, 1024>(lds, S, E, wv); }
        GSYNC();
        phase_norm_res<true, true>(Yb, fresh(p)->out, fresh(p)->out, fresh(p)->in[12] + (size_t)l * 1024, RS, wv);
        GSYNC();
        #define LOCAL_SEAM() do { asm volatile("s_waitcnt vmcnt(0)" ::: "memory"); __syncthreads(); } while (0)
        for (int rep = 0; rep < ((PROBE & 1) ? 2 : 1); ++rep) { pg8::SchedAttn<2> S{(const bf16_t*)fresh(p)->out, wl + WXQ_O, G, c}; pg8::EpiBf16 E{Yb, RS}; pg8::gemm_phase<1024, 1024, 1024>(lds, S, E, wv); }
        LOCAL_SEAM();
        for (int rep = 0; rep < ((PROBE & 1) ? 2 : 1); ++rep) { pg8::SchedAttn<0> S{Yb, KB + (size_t)l * 2048 * 1024, G, c}; pg8::EpiSoftmax E{Hb, 0.0625f * 1.4426950408889634f, (LAS float*)(lds + pg8::STAGE_BYTES)}; pg8::gemm_phase<1024, 1024, 256>(lds, S, E, wv); }
        LOCAL_SEAM();
        for (int rep = 0; rep < ((PROBE & 1) ? 2 : 1); ++rep) { pg8::SchedAttn<1> S{Hb, VT + (size_t)l * 8 * 1024 * 256, G, c}; pg8::EpiBf16 E{Yb}; pg8::gemm_phase<1024, 256, 256>(lds, S, E, wv); }
        GSYNC();
        for (int rep = 0; rep < ((PROBE & 1) ? 2 : 1); ++rep) { pg8::SchedStd<0> S{Yb, wl + WXO_O, 128, 4, 1024, 1024, 1024, G, c}; pg8::EpiBf16 E{Hb}; pg8::gemm_phase<1024, 1024, 1024>(lds, S, E, wv); }
        GSYNC();
        phase_norm_res<true, true>(Hb, fresh(p)->out, l + 1 < DEPTH ? (void*)fresh(p)->out : (void*)W, fresh(p)->in[18] + (size_t)l * 1024, RS, wv);
        GSYNC();
        for (int rep = 0; rep < ((PROBE & 1) ? 2 : 1); ++rep) { pg8::SchedStd<1> S{l + 1 < DEPTH ? (const bf16_t*)fresh(p)->out : (const bf16_t*)W, wl + WGU_O, 128, 22, 1024, 1024, DFF, G, c}; pg8::EpiSwiglu E{Hb, RS}; pg8::gemm_phase<1024, 1024, 1024>(lds, S, E, wv); }
        GSYNC();
        for (int rep = 0; rep < ((PROBE & 1) ? 2 : 1); ++rep) { pg8::SchedStd<0> S{Hb, wl + WDN_O, 128, 4, DFF, DFF, 1024, G, c}; pg8::EpiBf16 E{Yb}; pg8::gemm_phase<DFF, DFF, DFF>(lds, S, E, wv); }
        GSYNC();
        if (l + 1 < DEPTH) phase_norm_res<true, true>(Yb, fresh(p)->out, fresh(p)->out, fresh(p)->in[22] + (size_t)l * 1024, RS, wv);
        else phase_norm_res<true, false>(Yb, (const void*)W, fresh(p)->out, fresh(p)->in[22] + (size_t)l * 1024, nullptr, wv);
        if (l + 1 < DEPTH) GSYNC();
    }
}

extern "C" void kernel_launch(void* const* d_in, const int* in_sizes, int n_in, void* d_out, int out_size, void* d_ws, size_t ws_size, hipStream_t stream) {
    static int grid_blocks = 0;
    if (grid_blocks == 0) {
        if (n_in != 23 || ws_size < WS_END) { fprintf(stderr, "kernel_launch: unexpected n_in %d / ws_size %zu\n", n_in, ws_size); grid_blocks = -1; return; }
        int dev = 0, cus = 0, per_cu = 0;
        hipGetDevice(&dev);
        hipDeviceGetAttribute(&cus, hipDeviceAttributeMultiprocessorCount, dev);
        if (hipFuncSetAttribute((const void*)fwd_megakernel, hipFuncAttributeMaxDynamicSharedMemorySize, LDS_BYTES) != hipSuccess) { fprintf(stderr, "kernel_launch: hipFuncSetAttribute failed\n"); grid_blocks = -1; return; }
        if (hipOccupancyMaxActiveBlocksPerMultiprocessor(&per_cu, (const void*)fwd_megakernel, 512, LDS_BYTES) != hipSuccess || per_cu < 1) { fprintf(stderr, "kernel_launch: occupancy query failed (%d)\n", per_cu); (void)hipGetLastError(); per_cu = 1; }
        grid_blocks = cus * 1;
        fprintf(stderr, "kernel_launch: cus %d per_cu %d grid %d\n", cus, per_cu, grid_blocks);
    }
    if (grid_blocks < 0) return;
    if (hipMemsetAsync((char*)d_ws + WS_BAR, 0, XCD_BAR_WORDS * 4, stream) != hipSuccess) { fprintf(stderr, "kernel_launch: memset of barrier words failed\n"); return; }
    Params p{};
    for (int i = 0; i < 23; ++i) p.in[i] = (const float*)d_in[i];
    p.out = (float*)d_out; p.ws = (unsigned char*)d_ws;
    void* args[] = {&p};
    hipError_t e = hipLaunchCooperativeKernel((const void*)fwd_megakernel, dim3(grid_blocks), dim3(512), args, LDS_BYTES, stream);
    if (e != hipSuccess) fprintf(stderr, "cooperative launch failed: %s (grid %d)\n", hipGetErrorString(e), grid_blocks);
}
```

```cpp
#include <hip/hip_runtime.h>
#include <hip/hip_cooperative_groups.h>
#include <cstdio>
namespace cg = cooperative_groups;

#define LAS __attribute__((address_space(3)))
typedef unsigned short bf16_t;
typedef short bf16x8 __attribute__((ext_vector_type(8)));
typedef float f32x4 __attribute__((ext_vector_type(4)));
typedef unsigned u32x4 __attribute__((ext_vector_type(4)));
typedef unsigned u32x2 __attribute__((ext_vector_type(2)));

constexpr int BATCH = 8, SEQ = 4096, DM = 1024, MTOK = BATCH * SEQ, NMEM = 256, DEPTH = 4;
constexpr int DIN = 2576, DINP = 2816, DFF = 2816;
constexpr int OFF_Q = 0, OFF_K = 256, OFF_V = 512, OFF_G = 1024, OFF_A = 1536, OFF_U = 1552, OFF_SV = 2064;
constexpr float EPS = 1e-6f;
constexpr int PROBE = 0;

constexpr size_t WIN_O = 0, WOUT_O = 2883584, WXQ_O = 3932160, WXKV_O = 4980736, WXO_O = 7077888, WGU_O = 8126464, WDN_O = 13893632, WL_SZ = 16777216;
constexpr size_t MiB = 1048576;
constexpr size_t WS_W = 0, WS_K = 128 * MiB, WS_VT = 144 * MiB, WS_XN = 160 * MiB, WS_H = 224 * MiB, WS_Y = 400 * MiB, WS_AC = 464 * MiB, WS_BAR = 465 * MiB, WS_MEMN = 466 * MiB, WS_END = 482 * MiB;

constexpr int LDS_MAIN = 139264, LDS_BYTES = LDS_MAIN + 16;

struct Params {
    const float* in[23];
    float* out;
    unsigned char* ws;
};
typedef const __attribute__((address_space(4))) Params* KP;
__device__ __forceinline__ KP fresh(KP k) { asm volatile("" : "+s"(k)); return k; }

typedef __bf16 bf16v2 __attribute__((ext_vector_type(2)));
typedef float f32v2 __attribute__((ext_vector_type(2)));
__device__ __forceinline__ unsigned cvt_pk_bf16(float lo, float hi) { const f32v2 f = {lo, hi}; return __builtin_bit_cast(unsigned, __builtin_convertvector(f, bf16v2)); }
__device__ __forceinline__ int otid(int wv) { int t; asm volatile("v_mbcnt_lo_u32_b32 %0, -1, 0\n\tv_mbcnt_hi_u32_b32 %0, -1, %0\n\tv_lshl_add_u32 %0, %1, 6, %0" : "=&v"(t) : "s"(wv)); return t; }
__device__ __forceinline__ float bf_lo(unsigned w) { return __uint_as_float(w << 16); }
__device__ __forceinline__ float bf_hi(unsigned w) { return __uint_as_float(w & 0xffff0000u); }
__device__ __forceinline__ float bf2f(bf16_t b) { return __uint_as_float(((unsigned)b) << 16); }
__device__ __forceinline__ float shx(float v, int m, int lane) { return __int_as_float(__builtin_amdgcn_ds_bpermute((lane ^ m) << 2, __float_as_int(v))); }
#define DPP_ADD(v, ctrl, rmask) ((v) + __int_as_float(__builtin_amdgcn_update_dpp(0, __float_as_int(v), (ctrl), (rmask), 0xf, false)))
__device__ __forceinline__ float row8_sum(float v) { v = DPP_ADD(v, 0xB1, 0xf); v = DPP_ADD(v, 0x4E, 0xf); v = DPP_ADD(v, 0x141, 0xf); return v; }
__device__ __forceinline__ float wave_sum(float v, int) {
    v = row8_sum(v); v = DPP_ADD(v, 0x140, 0xf); v = DPP_ADD(v, 0x142, 0xa); v = DPP_ADD(v, 0x143, 0xc);
    return __int_as_float(__builtin_amdgcn_readlane(__float_as_int(v), 63));
}
__device__ __forceinline__ float gelu_tanh(float x) {
    const float y2 = 1.5957691216057308f * (x + 0.044715f * x * x * x);
    return x * __builtin_amdgcn_rcpf(1.0f + __expf(-y2));
}
__device__ __forceinline__ float silu_f(float x) { return x * __builtin_amdgcn_rcpf(1.0f + __expf(-x)); }
__device__ __forceinline__ float logsigmoid_f(float z) { return fminf(z, 0.0f) - __logf(1.0f + __expf(-fabsf(z))); }

namespace pg8 {
constexpr int BM = 256, BK = 64, HALF = 128, HTB = HALF * BK * 2, STAGE_BYTES = 8 * HTB, NXCD = 8, WGM = 8;
__device__ __forceinline__ int lds_byte(int r, int c) { const int st = (r >> 4) * 2 + (c >> 5), rr = r & 15, cc = c & 31, ob = rr * 64 + cc * 2; return st * 1024 + (ob ^ (((ob >> 9) & 1) << 5)); }
__device__ __forceinline__ void stage_rc(int b, int& R, int& C) { const int st = b / 1024, sb = b % 1024, swz = sb ^ (((sb >> 9) & 1) << 5); R = (st >> 1) * 16 + swz / 64; C = (st & 1) * 32 + (swz % 64) / 2; }
__device__ __forceinline__ int perm32(int rho) { const int n = rho >> 4, i = rho & 15; return 8 * (i >> 2) + 4 * n + (i & 3); }

struct Unit { const char* a; const char* b; size_t o; int ldc; int row0; };

__device__ __forceinline__ bool std_tile(int i, int G, int c, int nM, int nN, int& pm, int& pn) {
    const int nwg = nM * nN; const long L = (long)i * G + c; if (L >= nwg) return false;
    int wgid = (int)L; { const int q = nwg / NXCD, r = nwg % NXCD, xcd = wgid % NXCD, off = wgid / NXCD; wgid = (xcd < r ? xcd * (q + 1) : r * (q + 1) + (xcd - r) * q) + off; }
    const int nig = WGM * nN, gid = wgid / nig, fm = gid * WGM, gsz = (nM - fm) < WGM ? (nM - fm) : WGM;
    pm = fm + ((wgid % nig) % gsz); pn = (wgid % nig) / gsz; return true;
}
template <int MODE> struct SchedStd {
    const bf16_t* A; const bf16_t* Bt; int nM, nN, lda, ldb, ldc, G, c;
    __device__ __forceinline__ bool next(int i, Unit& u) const {
        int pm, pn; if (!std_tile(i, G, c, nM, nN, pm, pn)) return false;
        u.a = (const char*)(A + (size_t)pm * 256 * lda); u.b = (const char*)(Bt + (size_t)pn * 256 * ldb);
        u.o = (size_t)pm * 256 * ldc + (size_t)pn * (MODE == 1 ? 128 : 256); u.ldc = ldc; u.row0 = pm * 256; return true;
    }
};
struct SchedInKV {
    const bf16_t* A; const bf16_t* Bt; const bf16_t* memn; const bf16_t* Wkv; int l, G, c;
    __device__ __forceinline__ bool next(int i, Unit& u) const {
        int pm, pn;
        if (std_tile(i, G, c, 128, 11, pm, pn)) { u.a = (const char*)(A + (size_t)pm * 256 * 1024); u.b = (const char*)(Bt + (size_t)pn * 256 * 1024);
            u.o = WS_H / 2 + (size_t)pm * 256 * DINP + (size_t)pn * 256; u.ldc = DINP; u.row0 = pm * 256; return true; }
        const long r = (long)i * G + c - 1408; if (r >= 64) return false;
        u.row0 = -1;
        if (r < 32) { const int b = (int)r >> 2, pn2 = (int)r & 3; u.a = (const char*)(memn + (size_t)b * 256 * 1024); u.b = (const char*)(Wkv + (size_t)pn2 * 256 * 1024);
            u.o = WS_K / 2 + ((size_t)l * 2048 + b * 256) * 1024 + pn2 * 256; u.ldc = 1024; }
        else { const int rr = (int)r - 32, pm2 = rr >> 3, b = rr & 7; u.a = (const char*)(Wkv + (size_t)(1024 + pm2 * 256) * 1024); u.b = (const char*)(memn + (size_t)b * 256 * 1024);
            u.o = WS_VT / 2 + (((size_t)l * 8 + b) * 1024 + pm2 * 256) * 256; u.ldc = 256; }
        return true;
    }
};
struct SchedKV {
    const bf16_t* memn; const bf16_t* W; size_t kbase, vbase; int G, c;
    __device__ __forceinline__ bool next(int i, Unit& u) const {
        const long L = (long)i * G + c; if (L >= 256) return false;
        const int l = (int)L >> 6, r = (int)L & 63; const bf16_t* wl = W + (size_t)l * WL_SZ + WXKV_O; const bf16_t* ml = memn + (size_t)l * 2048 * 1024;
        if (r < 32) { const int b = r >> 2, pn = r & 3; u.a = (const char*)(ml + (size_t)b * 256 * 1024); u.b = (const char*)(wl + (size_t)pn * 256 * 1024);
            u.o = kbase + ((size_t)l * 2048 + b * 256) * 1024 + pn * 256; u.ldc = 1024; u.row0 = 0; }
        else { const int rr = r - 32, pm = rr >> 3, b = rr & 7; u.a = (const char*)(wl + (size_t)(1024 + pm * 256) * 1024); u.b = (const char*)(ml + (size_t)b * 256 * 1024);
            u.o = vbase + (((size_t)l * 8 + b) * 1024 + pm * 256) * 256; u.ldc = 256; u.row0 = 0; }
        return true;
    }
};
template <int MODE> struct SchedAttn {
    const bf16_t* A; const bf16_t* Bm; int G, c;
    __device__ __forceinline__ bool next(int i, Unit& u) const {
        const long L = (long)i * G + c; if (L >= 512) return false;
        int pm = (int)L >> 2, h = (int)L & 3;
        if (G == 256) { pm = i * 64 + (c & 7) * 8 + (c >> 5); h = (c >> 3) & 3; }
        const int b = pm >> 4;
        u.a = (const char*)(A + (size_t)pm * 256 * 1024 + (MODE == 2 ? 0 : h * 256));
        u.b = MODE == 0 ? (const char*)(Bm + (size_t)b * 256 * 1024 + h * 256) : (MODE == 1 ? (const char*)(Bm + ((size_t)b * 1024 + h * 256) * 256) : (const char*)(Bm + (size_t)h * 256 * 1024));
        u.o = (size_t)pm * 256 * 1024 + h * 256; u.ldc = 1024; u.row0 = pm * 256; return true;
    }
};

struct EpiBf16 {
    static constexpr bool PERM = true, RSLDS = true; bf16_t* O; const float* rs = nullptr;
    __device__ __forceinline__ void operator()(const f32x4 (&acc)[2][2][4][2], const Unit& u, int wr, int wc, int fr, int fq, const LAS float* lrs) const {
        bf16_t* base = O + u.o + (size_t)(wr * 64 + fr) * u.ldc + wc * 32 + 8 * fq;
#pragma unroll
        for (int ai = 0; ai < 2; ++ai)
#pragma unroll
            for (int m = 0; m < 4; ++m) { bf16_t* rowp = base + (size_t)(ai * HALF + m * 16) * u.ldc; const float sc = (rs && u.row0 >= 0) ? lrs[ai * HALF + wr * 64 + m * 16 + fr] : 1.0f;
#pragma unroll
                for (int bj = 0; bj < 2; ++bj) { const f32x4 v0 = acc[ai][bj][m][0] * sc, v1 = acc[ai][bj][m][1] * sc;
                    u32x4 w; w.x = cvt_pk_bf16(v0[0], v0[1]); w.y = cvt_pk_bf16(v0[2], v0[3]); w.z = cvt_pk_bf16(v1[0], v1[1]); w.w = cvt_pk_bf16(v1[2], v1[3]);
                    *(u32x4*)(rowp + bj * HALF) = w; } }
    }
};
struct EpiSwiglu {
    static constexpr bool PERM = true, RSLDS = true; bf16_t* O; const float* rs;
    __device__ __forceinline__ void operator()(const f32x4 (&acc)[2][2][4][2], const Unit& u, int wr, int wc, int fr, int fq, const LAS float* lrs) const {
        bf16_t* base = O + u.o + (size_t)(wr * 64 + fr) * u.ldc + wc * 32 + 8 * fq;
#pragma unroll
        for (int ai = 0; ai < 2; ++ai)
#pragma unroll
            for (int m = 0; m < 4; ++m) { bf16_t* rowp = base + (size_t)(ai * HALF + m * 16) * u.ldc; const float sc = lrs[ai * HALF + wr * 64 + m * 16 + fr];
                float r[8];
#pragma unroll
                for (int n = 0; n < 2; ++n)
#pragma unroll
                    for (int e = 0; e < 4; ++e) r[n * 4 + e] = silu_f(acc[ai][0][m][n][e] * sc) * (acc[ai][1][m][n][e] * sc);
                u32x4 w; w.x = cvt_pk_bf16(r[0], r[1]); w.y = cvt_pk_bf16(r[2], r[3]); w.z = cvt_pk_bf16(r[4], r[5]); w.w = cvt_pk_bf16(r[6], r[7]);
                *(u32x4*)rowp = w; }
    }
};
struct EpiSoftmax {
    static constexpr bool PERM = true, RSLDS = false; bf16_t* O; float scale2; LAS float* st;
    __device__ __forceinline__ void operator()(f32x4 (&acc)[2][2][4][2], const Unit& u, int wr, int wc, int fr, int fq, const LAS float*) const {
#pragma unroll
        for (int ai = 0; ai < 2; ++ai)
#pragma unroll
            for (int m = 0; m < 4; ++m) { float mx = -3.0e38f;
#pragma unroll
                for (int bj = 0; bj < 2; ++bj)
#pragma unroll
                    for (int n = 0; n < 2; ++n)
#pragma unroll
                        for (int e = 0; e < 4; ++e) mx = fmaxf(mx, acc[ai][bj][m][n][e]);
                mx = fmaxf(mx, shx(mx, 16, fq * 16 + fr)); mx = fmaxf(mx, shx(mx, 32, fq * 16 + fr));
                if (fq == 0) st[(ai * HALF + wr * 64 + m * 16 + fr) * 4 + wc] = mx; }
        asm volatile("s_waitcnt lgkmcnt(0)" ::: "memory"); __builtin_amdgcn_s_barrier(); asm volatile("" ::: "memory");
#pragma unroll
        for (int ai = 0; ai < 2; ++ai)
#pragma unroll
            for (int m = 0; m < 4; ++m) { const int row = ai * HALF + wr * 64 + m * 16 + fr; const f32x4 m4 = *(const LAS f32x4*)(st + row * 4);
                const float mx = fmaxf(fmaxf(m4[0], m4[1]), fmaxf(m4[2], m4[3])); float sm = 0.f;
#pragma unroll
                for (int bj = 0; bj < 2; ++bj)
#pragma unroll
                    for (int n = 0; n < 2; ++n)
#pragma unroll
                        for (int e = 0; e < 4; ++e) { const float ex = __builtin_amdgcn_exp2f((acc[ai][bj][m][n][e] - mx) * scale2); acc[ai][bj][m][n][e] = ex; sm += ex; }
                sm += shx(sm, 16, fq * 16 + fr); sm += shx(sm, 32, fq * 16 + fr);
                if (fq == 0) st[1024 + row * 4 + wc] = sm; }
        asm volatile("s_waitcnt lgkmcnt(0)" ::: "memory"); __builtin_amdgcn_s_barrier(); asm volatile("" ::: "memory");
        bf16_t* base = O + u.o + (size_t)(wr * 64 + fr) * u.ldc + wc * 32 + 8 * fq;
#pragma unroll
        for (int ai = 0; ai < 2; ++ai)
#pragma unroll
            for (int m = 0; m < 4; ++m) { const int row = ai * HALF + wr * 64 + m * 16 + fr; const f32x4 s4 = *(const LAS f32x4*)(st + 1024 + row * 4);
                const float inv = 1.0f / ((s4[0] + s4[1]) + (s4[2] + s4[3])); bf16_t* rowp = base + (size_t)(ai * HALF + m * 16) * u.ldc;
#pragma unroll
                for (int bj = 0; bj < 2; ++bj) { const f32x4 v0 = acc[ai][bj][m][0] * inv, v1 = acc[ai][bj][m][1] * inv;
                    u32x4 w; w.x = cvt_pk_bf16(v0[0], v0[1]); w.y = cvt_pk_bf16(v0[2], v0[3]); w.z = cvt_pk_bf16(v1[0], v1[1]); w.w = cvt_pk_bf16(v1[2], v1[3]);
                    *(u32x4*)(rowp + bj * HALF) = w; } }
    }
};
struct EpiF32Scale {
    static constexpr bool PERM = false, RSLDS = false; float* O; float scale;
    __device__ __forceinline__ void operator()(const f32x4 (&acc)[2][2][4][2], const Unit& u, int wr, int wc, int fr, int fq, const LAS float*) const {
        float* base = O + u.o + (size_t)(wr * 64 + fr) * u.ldc + wc * 32 + 4 * fq;
#pragma unroll
        for (int ai = 0; ai < 2; ++ai)
#pragma unroll
            for (int m = 0; m < 4; ++m) { float* rowp = base + (size_t)(ai * HALF + m * 16) * u.ldc;
#pragma unroll
                for (int bj = 0; bj < 2; ++bj)
#pragma unroll
                    for (int n = 0; n < 2; ++n) *(f32x4*)(rowp + bj * HALF + n * 16) = acc[ai][bj][m][n] * scale; }
    }
};

template <int lda, int ldb, int K, class Epi, class Sched>
__device__ __forceinline__ void gemm_phase(LAS unsigned char* lds, const Sched& S, const Epi& E, const int wv) {
    const int tid = otid(wv), wid = __builtin_amdgcn_readfirstlane(tid >> 6), lane = tid & 63, wr = wid >> 2, wc = wid & 3, fr = lane & 15, fq = lane >> 4;
    const int nt = K / BK;
    unsigned voffA[2], voffB[2];
#pragma unroll
    for (int i = 0; i < 2; ++i) { int R, C; stage_rc(tid * 16 + i * 8192, R, C); const int Rb = Epi::PERM ? ((R & ~31) + perm32(R & 31)) : R;
        voffA[i] = (unsigned)(R * lda + C) * 2u; voffB[i] = (unsigned)(Rb * ldb + C) * 2u; }
    const size_t kstep = (size_t)(BK * 2);
    const size_t hstepA = (size_t)HALF * lda * 2, hstepB = (size_t)HALF * ldb * 2;
    const unsigned ldsw = (unsigned)wid * 1024u;
    const int aoff = lds_byte(wr * 64 + fr, fq * 8), boff = lds_byte(wc * 32 + fr, fq * 8);
#define PG8_SA(b, h) (((b) * 2 + (h)) * HTB)
#define PG8_SB(b, h) ((4 + (b) * 2 + (h)) * HTB)
#define PG8_STAGE(bufoff, gbase, voff) do { _Pragma("unroll") for (int _i = 0; _i < 2; ++_i) \
        __builtin_amdgcn_global_load_lds((const unsigned*)((const char*)(gbase) + (voff)[_i]), (LAS unsigned*)(lds + (bufoff) + ldsw + _i * 8192), 16, 0, 0); } while (0)
#define PG8_LDA(dst, b, h) do { _Pragma("unroll") for (int m = 0; m < 4; ++m) _Pragma("unroll") for (int k = 0; k < 2; ++k) dst[m][k] = *(const LAS bf16x8*)(lds + PG8_SA(b, h) + aoff + m * 2048 + k * 1024); } while (0)
#define PG8_LDB(dst, b, h) do { _Pragma("unroll") for (int n = 0; n < 2; ++n) _Pragma("unroll") for (int k = 0; k < 2; ++k) dst[n][k] = *(const LAS bf16x8*)(lds + PG8_SB(b, h) + boff + n * 2048 + k * 1024); } while (0)
#define PG8_MMA(ai, bj, At, Bt) do { __builtin_amdgcn_s_setprio(1); _Pragma("unroll") for (int m = 0; m < 4; ++m) _Pragma("unroll") for (int n = 0; n < 2; ++n) _Pragma("unroll") for (int k = 0; k < 2; ++k) \
        acc[ai][bj][m][n] = __builtin_amdgcn_mfma_f32_16x16x32_bf16(Bt[n][k], At[m][k], acc[ai][bj][m][n], 0, 0, 0); __builtin_amdgcn_s_setprio(0); } while (0)
#define PG8_WAIT_V(n) asm volatile("s_waitcnt vmcnt(" #n ")" ::: "memory")
#define PG8_WAIT_L(n) asm volatile("s_waitcnt lgkmcnt(" #n ")" ::: "memory")
#define PG8_BAR __builtin_amdgcn_s_barrier()
#define PG8_SCHED __builtin_amdgcn_sched_barrier(0)
    Unit cur, nxt; int ui = 0;
    if (!S.next(0, cur)) return;
    const char* cA = cur.a; const char* cB = cur.b;
    f32x4 acc[2][2][4][2];
#pragma unroll
    for (int a = 0; a < 2; ++a)
#pragma unroll
        for (int b = 0; b < 2; ++b)
#pragma unroll
            for (int m = 0; m < 4; ++m)
#pragma unroll
                for (int n = 0; n < 2; ++n) acc[a][b][m][n] = (f32x4){0.f, 0.f, 0.f, 0.f};
    bf16x8 At[4][2], B0[2][2], B1[2][2];
    PG8_STAGE(PG8_SB(0, 0), cB, voffB); PG8_STAGE(PG8_SB(0, 1), cB + hstepB, voffB); PG8_STAGE(PG8_SA(0, 0), cA, voffA); PG8_STAGE(PG8_SA(0, 1), cA + hstepA, voffA);
    if (wr == 1) PG8_BAR;
    PG8_WAIT_V(2); PG8_BAR;
    PG8_STAGE(PG8_SB(1, 0), cB + kstep, voffB); PG8_STAGE(PG8_SA(1, 0), cA + kstep, voffA); PG8_STAGE(PG8_SB(1, 1), cB + hstepB + kstep, voffB);
    PG8_WAIT_V(6); PG8_BAR;
    for (;;) {
        const bool has_next = S.next(ui + 1, nxt);
        const char* nA = has_next ? nxt.a : cA; const char* nB = has_next ? nxt.b : cB;
#pragma unroll 1
        for (int t = 0; t < nt; t += 2) {
            const bool last = (t == nt - 2);
            if constexpr (Epi::RSLDS) { if (t == 0 && wid < 4 && E.rs != nullptr && cur.row0 >= 0)
                __builtin_amdgcn_global_load_lds((const unsigned*)(E.rs + cur.row0 + wid * 64 + lane), (LAS unsigned*)(lds + STAGE_BYTES + (ui & 1) * 1024 + wid * 256), 4, 0, 0); }
            const char* a1 = cA + (size_t)(t + 1) * kstep;
            const char* a2 = last ? nA : cA + (size_t)(t + 2) * kstep; const char* b2 = last ? nB : cB + (size_t)(t + 2) * kstep;
            const char* a3 = a2 + kstep; const char* b3 = b2 + kstep;
            PG8_LDB(B0, 0, 0); PG8_LDB(B1, 0, 1); PG8_SCHED; PG8_LDA(At, 0, 0); PG8_STAGE(PG8_SA(1, 1), a1 + hstepA, voffA);
            PG8_WAIT_V(8); PG8_WAIT_L(0); PG8_BAR; PG8_MMA(0, 0, At, B0); PG8_MMA(0, 1, At, B1); PG8_BAR; PG8_SCHED;
            PG8_LDA(At, 0, 1); PG8_STAGE(PG8_SB(0, 0), b2, voffB); PG8_STAGE(PG8_SB(0, 1), b2 + hstepB, voffB); PG8_STAGE(PG8_SA(0, 0), a2, voffA);
            PG8_WAIT_V(8); PG8_WAIT_L(0); PG8_BAR; PG8_MMA(1, 0, At, B0); PG8_MMA(1, 1, At, B1); PG8_BAR; PG8_SCHED;
            PG8_LDB(B0, 1, 0); PG8_LDB(B1, 1, 1); PG8_SCHED; PG8_LDA(At, 1, 0); PG8_STAGE(PG8_SA(0, 1), a2 + hstepA, voffA);
            PG8_WAIT_V(8); PG8_WAIT_L(0); PG8_BAR; PG8_MMA(0, 0, At, B0); PG8_MMA(0, 1, At, B1); PG8_BAR; PG8_SCHED;
            PG8_LDA(At, 1, 1); PG8_STAGE(PG8_SB(1, 0), b3, voffB); PG8_STAGE(PG8_SB(1, 1), b3 + hstepB, voffB); PG8_STAGE(PG8_SA(1, 0), a3, voffA);
            PG8_WAIT_V(8); PG8_WAIT_L(0); PG8_BAR; PG8_MMA(1, 0, At, B0); PG8_MMA(1, 1, At, B1); PG8_BAR; PG8_SCHED;
        }
        if (wr == 0) PG8_BAR;
        { const int l2 = otid(wv) & 63; E(acc, cur, wr, wc, l2 & 15, l2 >> 4, (const LAS float*)(lds + STAGE_BYTES + (ui & 1) * 1024)); }
        if (!has_next) break;
#pragma unroll
        for (int a = 0; a < 2; ++a)
#pragma unroll
            for (int b = 0; b < 2; ++b)
#pragma unroll
                for (int m = 0; m < 4; ++m)
#pragma unroll
                    for (int n = 0; n < 2; ++n) acc[a][b][m][n] = (f32x4){0.f, 0.f, 0.f, 0.f};
        cur = nxt; cA = nA; cB = nB; ++ui;
        if (wr == 1) PG8_BAR;
    }
    PG8_WAIT_V(0);
    PG8_BAR;
#undef PG8_SA
#undef PG8_SB
#undef PG8_STAGE
#undef PG8_LDA
#undef PG8_LDB
#undef PG8_MMA
#undef PG8_WAIT_V
#undef PG8_WAIT_L
#undef PG8_BAR
#undef PG8_SCHED
}
}

struct ConvUnit { const float* src; bf16_t* dst; int Nsrc, k0, n0, ldd, drow0; const float* gk; };
__device__ __forceinline__ ConvUnit conv_decode(KP p, int t) {
    bf16_t* W = (bf16_t*)(p->ws + WS_W); const int l = t >> 10, r = t & 1023; bf16_t* wl = W + (size_t)l * WL_SZ; ConvUnit u;
    if (r < 176) { const int tn = r >> 2, kg = r & 3; u = ConvUnit{p->in[3] + (size_t)l * 1024 * DIN, wl + WIN_O, DIN, kg * 256, tn * 64, 1024, tn * 64, p->in[2] + (size_t)l * 1024}; }
    else if (r < 240) { const int q = r - 176, tn = q >> 2, kg = q & 3; u = ConvUnit{p->in[11] + (size_t)l * 1024 * 1024, wl + WOUT_O, 1024, kg * 256, tn * 64, 1024, tn * 64, nullptr}; }
    else if (r < 304) { const int q = r - 240, tn = q >> 2, kg = q & 3; u = ConvUnit{p->in[15] + (size_t)l * 1024 * 1024, wl + WXQ_O, 1024, kg * 256, tn * 64, 1024, tn * 64, p->in[13] + (size_t)l * 1024}; }
    else if (r < 432) { const int q = r - 304, tn = q >> 2, kg = q & 3; u = ConvUnit{p->in[16] + (size_t)l * 1024 * 2048, wl + WXKV_O, 2048, kg * 256, tn * 64, 1024, tn * 64, nullptr}; }
    else if (r < 496) { const int q = r - 432, tn = q >> 2, kg = q & 3; u = ConvUnit{p->in[17] + (size_t)l * 1024 * 1024, wl + WXO_O, 1024, kg * 256, tn * 64, 1024, tn * 64, nullptr}; }
    else if (r < 848) { const int q = r - 496, tn = q >> 2, kg = q & 3; const int n0 = tn * 64, isup = n0 >= DFF, j0 = isup ? n0 - DFF : n0;
        u = ConvUnit{p->in[20] + (size_t)l * 1024 * 2 * DFF, wl + WGU_O, 2 * DFF, kg * 256, n0, 1024, (j0 >> 7) * 256 + (isup ? 128 : 0) + (j0 & 127), p->in[19] + (size_t)l * 1024}; }
    else { const int q = r - 848, tn = q / 11, kg = q % 11; u = ConvUnit{p->in[21] + (size_t)l * DFF * 1024, wl + WDN_O, 1024, kg * 256, tn * 64, DFF, tn * 64, nullptr}; }
    return u;
}
__device__ __forceinline__ void conv_load(const ConvUnit& u, int tid, float4 (&v)[4][2]) {
#pragma unroll
    for (int i = 0; i < 4; ++i) { const int idx = tid + 512 * i, rp = idx >> 4, c4 = (idx & 15) * 4;
#pragma unroll
        for (int h = 0; h < 2; ++h) { const int r = 2 * rp + h; v[i][h] = make_float4(0.f, 0.f, 0.f, 0.f);
            if (u.n0 + c4 < u.Nsrc) { const f32x4 t4 = __builtin_nontemporal_load((const f32x4*)(u.src + (size_t)(u.k0 + r) * u.Nsrc + u.n0 + c4)); const float g = u.gk ? u.gk[u.k0 + r] : 1.0f;
                v[i][h] = make_float4(t4[0] * g, t4[1] * g, t4[2] * g, t4[3] * g); } } }
}
__device__ void phase_convert_weights(KP p, float* sT_, int wv) {
    unsigned* sT = (unsigned*)sT_;
    const int tid = otid(wv); int t = blockIdx.x; if (t >= DEPTH * 1024) return;
    ConvUnit u = conv_decode(p, t); float4 v[4][2]; conv_load(u, tid, v);
    for (;;) {
#pragma unroll
        for (int i = 0; i < 4; ++i) { const int idx = tid + 512 * i, rp = idx >> 4, c4 = (idx & 15) * 4;
            sT[(c4 + 0) * 129 + rp] = cvt_pk_bf16(v[i][0].x, v[i][1].x); sT[(c4 + 1) * 129 + rp] = cvt_pk_bf16(v[i][0].y, v[i][1].y);
            sT[(c4 + 2) * 129 + rp] = cvt_pk_bf16(v[i][0].z, v[i][1].z); sT[(c4 + 3) * 129 + rp] = cvt_pk_bf16(v[i][0].w, v[i][1].w); }
        __syncthreads();
        const ConvUnit cu = u; const int tn = t + gridDim.x; const bool more = tn < DEPTH * 1024;
        if (more) { u = conv_decode(p, tn); conv_load(u, tid, v); }
#pragma unroll
        for (int i = 0; i < 4; ++i) { const int q = tid + 512 * i, nl = q & 63, kc = q >> 6;
            u32x4 w; w.x = sT[nl * 129 + kc * 4]; w.y = sT[nl * 129 + kc * 4 + 1]; w.z = sT[nl * 129 + kc * 4 + 2]; w.w = sT[nl * 129 + kc * 4 + 3];
            *(u32x4*)(cu.dst + (size_t)(cu.drow0 + nl) * cu.ldd + cu.k0 + kc * 8) = w; }
        __syncthreads();
        if (!more) break;
        t = tn;
    }
}
__device__ void rms_rows_bf16(const float* src, const float* g, bf16_t* dst, int nrows, int wv) {
    const int lane = otid(wv) & 63, gw = blockIdx.x * 8 + (otid(wv) >> 6), nw = gridDim.x * 8;
    for (int row0 = gw * 4; row0 < nrows; row0 += nw * 4) {
        float4 v[4][4];
#pragma unroll
        for (int r = 0; r < 4; ++r)
#pragma unroll
            for (int i = 0; i < 4; ++i) v[r][i] = ((const float4*)(src + (size_t)(row0 + r) * 1024))[i * 64 + lane];
#pragma unroll
        for (int r = 0; r < 4; ++r) { float ss = 0.f;
#pragma unroll
            for (int i = 0; i < 4; ++i) ss += v[r][i].x * v[r][i].x + v[r][i].y * v[r][i].y + v[r][i].z * v[r][i].z + v[r][i].w * v[r][i].w;
            ss = wave_sum(ss, lane); const float rs = rsqrtf(ss * (1.0f / 1024.0f) + EPS);
#pragma unroll
            for (int i = 0; i < 4; ++i) { const float4 gg = ((const float4*)g)[i * 64 + lane];
                u32x2 w; w.x = cvt_pk_bf16(v[r][i].x * rs * gg.x, v[r][i].y * rs * gg.y); w.y = cvt_pk_bf16(v[r][i].z * rs * gg.z, v[r][i].w * rs * gg.w);
                *(u32x2*)(dst + (size_t)(row0 + r) * 1024 + i * 256 + lane * 4) = w; } }
    }
}
__device__ void phase_x_init(const float* src, bf16_t* dst, float* rsout, int wv) {
    const int lane = otid(wv) & 63, gw = blockIdx.x * 8 + (otid(wv) >> 6), nw = gridDim.x * 8;
    for (int row0 = gw * 4; row0 < MTOK; row0 += nw * 4) {
        float4 v[4][4];
#pragma unroll
        for (int r = 0; r < 4; ++r)
#pragma unroll
            for (int i = 0; i < 4; ++i) v[r][i] = ((const float4*)(src + (size_t)(row0 + r) * 1024))[i * 64 + lane];
#pragma unroll
        for (int r = 0; r < 4; ++r) { float ss = 0.f;
#pragma unroll
            for (int i = 0; i < 4; ++i) { ss += v[r][i].x * v[r][i].x + v[r][i].y * v[r][i].y + v[r][i].z * v[r][i].z + v[r][i].w * v[r][i].w;
                u32x2 w; w.x = cvt_pk_bf16(v[r][i].x, v[r][i].y); w.y = cvt_pk_bf16(v[r][i].z, v[r][i].w);
                *(u32x2*)(dst + (size_t)(row0 + r) * 1024 + i * 256 + lane * 4) = w; }
            ss = wave_sum(ss, lane); if (lane == 0) rsout[row0 + r] = rsqrtf(ss * (1.0f / 1024.0f) + EPS); }
    }
}
template <bool XIN_BF, bool XOUT_BF>
__device__ void phase_norm_res(const bf16_t* y, const void* xin_, void* xout_, const float* gpost, float* rsout, int wv) {
    const int lane = otid(wv) & 63, gw = blockIdx.x * 8 + (otid(wv) >> 6), nw = gridDim.x * 8;
    for (int row0 = gw * 4; row0 < MTOK; row0 += nw * 4) {
        u32x2 yw[4][4]; float4 xv[4][4];
#pragma unroll
        for (int r = 0; r < 4; ++r)
#pragma unroll
            for (int i = 0; i < 4; ++i) { yw[r][i] = *(const u32x2*)(y + (size_t)(row0 + r) * 1024 + i * 256 + lane * 4);
                if (XIN_BF) { const u32x2 w = *(const u32x2*)((const bf16_t*)xin_ + (size_t)(row0 + r) * 1024 + i * 256 + lane * 4); xv[r][i] = make_float4(bf_lo(w.x), bf_hi(w.x), bf_lo(w.y), bf_hi(w.y)); }
                else xv[r][i] = ((const float4*)((const float*)xin_ + (size_t)(row0 + r) * 1024))[i * 64 + lane]; }
#pragma unroll
        for (int r = 0; r < 4; ++r) { float ss = 0.f; float yv[4][4];
#pragma unroll
            for (int i = 0; i < 4; ++i) { yv[i][0] = bf_lo(yw[r][i].x); yv[i][1] = bf_hi(yw[r][i].x); yv[i][2] = bf_lo(yw[r][i].y); yv[i][3] = bf_hi(yw[r][i].y);
#pragma unroll
                for (int e = 0; e < 4; ++e) ss += yv[i][e] * yv[i][e]; }
            ss = wave_sum(ss, lane); const float rs = rsqrtf(ss * (1.0f / 1024.0f) + EPS); float s2 = 0.f;
#pragma unroll
            for (int i = 0; i < 4; ++i) { const float4 gg = ((const float4*)gpost)[i * 64 + lane]; float4& x = xv[r][i];
                x.x += yv[i][0] * rs * gg.x; x.y += yv[i][1] * rs * gg.y; x.z += yv[i][2] * rs * gg.z; x.w += yv[i][3] * rs * gg.w;
                s2 += x.x * x.x + x.y * x.y + x.z * x.z + x.w * x.w;
                if (XOUT_BF) { u32x2 w; w.x = cvt_pk_bf16(x.x, x.y); w.y = cvt_pk_bf16(x.z, x.w); *(u32x2*)((bf16_t*)xout_ + (size_t)(row0 + r) * 1024 + i * 256 + lane * 4) = w; }
                else ((float4*)((float*)xout_ + (size_t)(row0 + r) * 1024))[i * 64 + lane] = x; }
            if (rsout) { s2 = wave_sum(s2, lane); if (lane == 0) rsout[row0 + r] = rsqrtf(s2 * (1.0f / 1024.0f) + EPS); } }
    }
}
__device__ __forceinline__ bf16x8 pack8(const float (&f)[8]) { u32x4 w; w.x = cvt_pk_bf16(f[0], f[1]); w.y = cvt_pk_bf16(f[2], f[3]); w.z = cvt_pk_bf16(f[4], f[5]); w.w = cvt_pk_bf16(f[6], f[7]); return __builtin_bit_cast(bf16x8, w); }
__device__ __forceinline__ void unpack8(const u32x4 w, float (&f)[8]) { f[0] = bf_lo(w.x); f[1] = bf_hi(w.x); f[2] = bf_lo(w.y); f[3] = bf_hi(w.y); f[4] = bf_lo(w.z); f[5] = bf_hi(w.z); f[6] = bf_lo(w.w); f[7] = bf_hi(w.w); }

__device__ void phase_gla_chunk(KP p, int l, LAS unsigned char* lds, int wv) {
    asm volatile("" : "+s"(p));
    const bf16_t* H = (const bf16_t*)(p->ws + WS_H); bf16_t* UB = (bf16_t*)(p->ws + WS_Y); float* AC = (float*)(p->ws + WS_AC);
    const float* wg = p->in[4] + (size_t)l * 16 * 256; const float* bg = p->in[5] + (size_t)l * 256;
    const int tid = otid(wv), lane = tid & 63, fr = lane & 15, fq = lane >> 4, c = tid & 63, seg = tid >> 6;
    int u = blockIdx.x; if (u >= 2048) return;
    u32x4 aw = (u32x4){0u, 0u, 0u, 0u}; u32x4 vw[2]; bf16_t kn[8];
#define GC_LOAD(uu) do { const int hd_ = (uu) & 3, n_ = ((uu) >> 2) & 63, b_ = (uu) >> 8; const size_t t0_ = (size_t)b_ * SEQ + n_ * 64; \
        if (tid < 128) aw = *(const u32x4*)(H + (t0_ + (tid >> 1)) * DINP + OFF_A + (tid & 1) * 8); \
        _Pragma("unroll") for (int i = 0; i < 2; ++i) { const int idx = tid + 512 * i; vw[i] = *(const u32x4*)(H + (t0_ + (idx & 63)) * DINP + OFF_V + hd_ * 128 + (idx >> 6) * 8); } \
        _Pragma("unroll") for (int i = 0; i < 8; ++i) kn[i] = H[(t0_ + seg * 8 + i) * DINP + OFF_K + hd_ * 64 + c]; } while (0)
    GC_LOAD(u);
    int hd_prev = -1; float wr_[16]; float bgc = 0.f;
#pragma unroll
    for (int r = 0; r < 16; ++r) wr_[r] = 0.f;
    for (int it = 0;; ++it) {
        LAS float* sA = (LAS float*)(lds + (it & 1) * 33792); LAS float* sTot = sA + 1024; LAS bf16_t* kdT = (LAS bf16_t*)(sTot + 512); LAS bf16_t* vT = kdT + 64 * 72;
        const int hd = u & 3;
        if (hd != hd_prev) { hd_prev = hd; bgc = bg[hd * 64 + c];
#pragma unroll
            for (int r = 0; r < 16; ++r) wr_[r] = wg[r * 256 + hd * 64 + c]; }
        if (tid < 128) { float f[8]; unpack8(aw, f); LAS float* d = sA + (tid >> 1) * 16 + (tid & 1) * 8; *(LAS f32x4*)d = (f32x4){f[0], f[1], f[2], f[3]}; *(LAS f32x4*)(d + 4) = (f32x4){f[4], f[5], f[6], f[7]}; }
#pragma unroll
        for (int i = 0; i < 2; ++i) { const int idx = tid + 512 * i, tok = idx & 63, c8 = (idx >> 6) * 8; const unsigned ww[4] = {vw[i].x, vw[i].y, vw[i].z, vw[i].w};
#pragma unroll
            for (int j = 0; j < 8; ++j) vT[(c8 + j) * 72 + tok] = (bf16_t)((j & 1) ? (ww[j >> 1] >> 16) : (ww[j >> 1] & 0xffffu)); }
        float kk[8];
#pragma unroll
        for (int i = 0; i < 8; ++i) kk[i] = bf2f(kn[i]);
        __syncthreads();
        const int un = u + gridDim.x; const bool more = un < 2048;
        if (more) GC_LOAD(un);
        float cl[8]; float run = 0.f;
#pragma unroll
        for (int i = 0; i < 8; ++i) { const LAS float* a = sA + (seg * 8 + i) * 16; float z = bgc;
#pragma unroll
            for (int r = 0; r < 16; ++r) z += a[r] * wr_[r];
            run += logsigmoid_f(z) * (1.0f / 16.0f); cl[i] = run; }
        sTot[seg * 64 + c] = run;
        __syncthreads();
        float pre = 0.f, tot = 0.f;
#pragma unroll
        for (int s = 0; s < 8; ++s) { const float v = sTot[s * 64 + c]; tot += v; if (s < seg) pre += v; }
        { float kd[8];
#pragma unroll
            for (int i = 0; i < 8; ++i) kd[i] = kk[i] * __expf(tot - (pre + cl[i]));
            *(LAS bf16x8*)(kdT + c * 72 + seg * 8) = pack8(kd); }
        if (seg == 0) AC[(size_t)u * 64 + c] = __expf(tot);
        __syncthreads();
        { bf16x8 bv[2];
#pragma unroll
            for (int ks = 0; ks < 2; ++ks) bv[ks] = *(const LAS bf16x8*)(vT + (wv * 16 + fr) * 72 + (ks * 4 + fq) * 8);
            bf16_t* ub = UB + (size_t)u * 8192 + (wv * 16 + fr) * 64 + fq * 4;
#pragma unroll
            for (int mt = 0; mt < 4; ++mt) { f32x4 acc = (f32x4){0.f, 0.f, 0.f, 0.f};
#pragma unroll
                for (int ks = 0; ks < 2; ++ks) { const bf16x8 av = *(const LAS bf16x8*)(kdT + (mt * 16 + fr) * 72 + (ks * 4 + fq) * 8);
                    acc = __builtin_amdgcn_mfma_f32_16x16x32_bf16(av, bv[ks], acc, 0, 0, 0); }
                u32x2 w; w.x = cvt_pk_bf16(acc[0], acc[1]); w.y = cvt_pk_bf16(acc[2], acc[3]); *(u32x2*)(ub + mt * 16) = w; } }
        if (!more) break;
        u = un;
    }
#undef GC_LOAD
    __syncthreads();
}
__device__ void phase_gla_scan(KP p, int wv) {
    asm volatile("" : "+s"(p));
    unsigned* UB = (unsigned*)(p->ws + WS_Y); const float* AC = (const float*)(p->ws + WS_AC);
    for (int e = blockIdx.x * 512 + otid(wv); e < 131072; e += gridDim.x * 512) {
        const int k2 = e & 31, v = (e >> 5) & 127, hd = (e >> 12) & 3, b = e >> 14;
        unsigned* ub = UB + (((size_t)b * 256 + hd) * 8192 + v * 64 + k2 * 2) / 2; const float* ab = AC + ((size_t)b * 256 + hd) * 64 + k2 * 2;
        float2 s = make_float2(0.f, 0.f);
        for (int n0 = 0; n0 < 64; n0 += 32) { unsigned uu[32]; float2 aa[32];
#pragma unroll
            for (int j = 0; j < 32; ++j) { uu[j] = ub[(size_t)(n0 + j) * 16384]; aa[j] = *(const float2*)(ab + (n0 + j) * 256); }
#pragma unroll
            for (int j = 0; j < 32; ++j) { s.x = aa[j].x * s.x + bf_lo(uu[j]); s.y = aa[j].y * s.y + bf_hi(uu[j]); ub[(size_t)(n0 + j) * 16384] = cvt_pk_bf16(s.x, s.y); } }
    }
}
__device__ void phase_gla_out(KP p, int l, LAS unsigned char* lds, int wv) {
    asm volatile("" : "+s"(p));
    LAS float* sO0 = (LAS float*)lds;
    const bf16_t* H = (const bf16_t*)(p->ws + WS_H); const bf16_t* UB = (const bf16_t*)(p->ws + WS_Y); bf16_t* MIX = (bf16_t*)(p->ws + WS_XN);
    const float* onorm = p->in[6] + (size_t)l * 512; const int tid = otid(wv), lane = tid & 63, fr = lane & 15, fq = lane >> 4;
    const int tt = tid >> 3, v0 = (tid & 7) * 16;
    int u = blockIdx.x; if (u >= 2048) return;
    bf16x8 bsn[2]; bf16x8 av[4][2]; u32x4 gw[2];
#define GO_LOAD(uu) do { const int hd_ = (uu) & 3, n_ = ((uu) >> 2) & 63, b_ = (uu) >> 8; const size_t t0_ = (size_t)b_ * SEQ + n_ * 64; \
        _Pragma("unroll") for (int ks = 0; ks < 2; ++ks) bsn[ks] = *(const bf16x8*)(UB + (size_t)(uu) * 8192 + (wv * 16 + fr) * 64 + ks * 32 + fq * 8); \
        _Pragma("unroll") for (int mt = 0; mt < 4; ++mt) _Pragma("unroll") for (int ks = 0; ks < 2; ++ks) av[mt][ks] = *(const bf16x8*)(H + (t0_ + mt * 16 + fr) * DINP + OFF_Q + hd_ * 64 + ks * 32 + fq * 8); \
        _Pragma("unroll") for (int h8 = 0; h8 < 2; ++h8) gw[h8] = *(const u32x4*)(H + (t0_ + tt) * DINP + OFF_G + hd_ * 128 + v0 + h8 * 8); } while (0)
    GO_LOAD(u);
    for (int it = 0;; ++it) {
        LAS float* sO = sO0 + (it & 1) * (64 * 132);
        const int hd = u & 3, n = (u >> 2) & 63, b = u >> 8; const size_t t0 = (size_t)b * SEQ + n * 64;
        const bf16x8 bs[2] = {bsn[0], bsn[1]};
#pragma unroll
        for (int mt = 0; mt < 4; ++mt) { f32x4 acc = (f32x4){0.f, 0.f, 0.f, 0.f};
#pragma unroll
            for (int ks = 0; ks < 2; ++ks) acc = __builtin_amdgcn_mfma_f32_16x16x32_bf16(av[mt][ks], bs[ks], acc, 0, 0, 0);
#pragma unroll
            for (int e = 0; e < 4; ++e) sO[(mt * 16 + fq * 4 + e) * 132 + wv * 16 + fr] = acc[e] * 0.125f; }
        float g[2][8]; unpack8(gw[0], g[0]); unpack8(gw[1], g[1]);
        __syncthreads();
        const int un = u + gridDim.x; const bool more = un < 2048;
        if (more) GO_LOAD(un);
        { f32x4 o[4]; float ss = 0.f;
#pragma unroll
            for (int q = 0; q < 4; ++q) { o[q] = *(const LAS f32x4*)(sO + tt * 132 + v0 + q * 4); ss += o[q][0] * o[q][0] + o[q][1] * o[q][1] + o[q][2] * o[q][2] + o[q][3] * o[q][3]; }
            ss = row8_sum(ss);
            const float rs = rsqrtf(ss * (1.0f / 128.0f) + EPS); bf16_t* op = MIX + (t0 + tt) * 1024 + hd * 128 + v0;
#pragma unroll
            for (int h8 = 0; h8 < 2; ++h8) { const float4 n0 = *(const float4*)(onorm + hd * 128 + v0 + h8 * 8), n1 = *(const float4*)(onorm + hd * 128 + v0 + h8 * 8 + 4);
                const f32x4 o0 = o[h8 * 2], o1 = o[h8 * 2 + 1];
                const float r[8] = {o0[0] * rs * n0.x * silu_f(g[h8][0]), o0[1] * rs * n0.y * silu_f(g[h8][1]), o0[2] * rs * n0.z * silu_f(g[h8][2]), o0[3] * rs * n0.w * silu_f(g[h8][3]),
                                    o1[0] * rs * n1.x * silu_f(g[h8][4]), o1[1] * rs * n1.y * silu_f(g[h8][5]), o1[2] * rs * n1.z * silu_f(g[h8][6]), o1[3] * rs * n1.w * silu_f(g[h8][7])};
                *(bf16x8*)(op + h8 * 8) = pack8(r); } }
        if (!more) break;
        u = un;
    }
#undef GO_LOAD
    __syncthreads();
}
__device__ void phase_sg(KP p, int l, LAS unsigned char* lds, int wv) {
    asm volatile("" : "+s"(p));
    LAS float* sStat = (LAS float*)lds; LAS bf16_t* svT0 = (LAS bf16_t*)(lds + 1024);
    const bf16_t* H = (const bf16_t*)(p->ws + WS_H); bf16_t* MIX = (bf16_t*)(p->ws + WS_XN); const bf16_t* WSB = (const bf16_t*)(p->ws + WS_AC + 524288) + (size_t)l * 4 * 128 * 128;
    const float* lng = p->in[7] + (size_t)l * 512; const float* lnb = p->in[8] + (size_t)l * 512; const float* bsp = p->in[10] + (size_t)l * 4 * 128;
    const int tid = otid(wv), lane = tid & 63, fr = lane & 15, fq = lane >> 4;
    for (int u = blockIdx.x; u < 256; u += gridDim.x) {
        const size_t t0 = (size_t)u * 128;
        for (int tb = 0; tb < 16; tb += 8) { u32x4 w8[8];
#pragma unroll
            for (int j = 0; j < 8; ++j) w8[j] = *(const u32x4*)(H + (t0 + wv * 16 + tb + j) * DINP + OFF_SV + lane * 8);
            float s1[8], s2[8];
#pragma unroll
            for (int j = 0; j < 8; ++j) { float f[8]; unpack8(w8[j], f); s1[j] = 0.f; s2[j] = 0.f;
#pragma unroll
                for (int e = 0; e < 8; ++e) { const float x = gelu_tanh(f[e]); s1[j] += x; s2[j] += x * x; } }
#pragma unroll
            for (int j = 0; j < 8; ++j) { s1[j] = wave_sum(s1[j], lane); s2[j] = wave_sum(s2[j], lane); }
            if (lane < 8) { float m1 = s1[0], m2 = s2[0];
#pragma unroll
                for (int j = 1; j < 8; ++j) if (lane == j) { m1 = s1[j]; m2 = s2[j]; }
                const float mu = m1 * (1.0f / 512.0f), var = fmaxf(m2 * (1.0f / 512.0f) - mu * mu, 0.f);
                sStat[(wv * 16 + tb + lane) * 2] = mu; sStat[(wv * 16 + tb + lane) * 2 + 1] = rsqrtf(var + EPS); } }
        __syncthreads();
        u32x4 svw[4];
#pragma unroll
        for (int it = 0; it < 4; ++it) { const int idx = tid + 512 * it, j = idx & 127, c8 = (idx >> 7) * 8; svw[it] = *(const u32x4*)(H + (t0 + j) * DINP + OFF_SV + c8); }
        for (int g = 0; g < 4; ++g) {
            LAS bf16_t* svT = svT0 + (g & 1) * (128 * 136);
            const int i = wv * 16 + fr; const size_t tok = t0 + i;
            bf16x8 wb[4]; u32x2 uw[8];
#pragma unroll
            for (int ks = 0; ks < 4; ++ks) wb[ks] = *(const bf16x8*)(WSB + ((size_t)g * 128 + i) * 128 + ks * 32 + fq * 8);
#pragma unroll
            for (int mt = 0; mt < 8; ++mt) uw[mt] = *(const u32x2*)(H + tok * DINP + OFF_U + g * 128 + mt * 16 + fq * 4);
            const float bs = bsp[g * 128 + i];
#pragma unroll
            for (int it = 0; it < 4; ++it) { const int idx = tid + 512 * it, j = idx & 127, c8 = (idx >> 7) * 8; float f[8];
                unpack8(svw[it], f);
                const float mu = sStat[j * 2], rs = sStat[j * 2 + 1];
#pragma unroll
                for (int e = 0; e < 8; ++e) { const float o = (gelu_tanh(f[e]) - mu) * rs * lng[g * 128 + c8 + e] + lnb[g * 128 + c8 + e];
                    svT[(c8 + e) * 136 + j] = (bf16_t)(cvt_pk_bf16(o, 0.f) & 0xffffu); } }
            __syncthreads();
            if (g < 3) {
#pragma unroll
                for (int it = 0; it < 4; ++it) { const int idx = tid + 512 * it, j = idx & 127, c8 = (idx >> 7) * 8; svw[it] = *(const u32x4*)(H + (t0 + j) * DINP + OFF_SV + (g + 1) * 128 + c8); } }
            f32x4 acc[8];
#pragma unroll
            for (int mt = 0; mt < 8; ++mt) { acc[mt] = (f32x4){0.f, 0.f, 0.f, 0.f};
#pragma unroll
                for (int ks = 0; ks < 4; ++ks) if (ks < 2 || wv >= 4) {
                    const bf16x8 av = *(const LAS bf16x8*)(svT + (mt * 16 + fr) * 136 + ks * 32 + fq * 8);
                    acc[mt] = __builtin_amdgcn_mfma_f32_16x16x32_bf16(av, wb[ks], acc[mt], 0, 0, 0); } }
#pragma unroll
            for (int mt = 0; mt < 8; ++mt) { const int cc = g * 128 + mt * 16 + fq * 4;
                const float r0 = gelu_tanh(bf_lo(uw[mt].x)) * (acc[mt][0] + bs), r1 = gelu_tanh(bf_hi(uw[mt].x)) * (acc[mt][1] + bs);
                const float r2 = gelu_tanh(bf_lo(uw[mt].y)) * (acc[mt][2] + bs), r3 = gelu_tanh(bf_hi(uw[mt].y)) * (acc[mt][3] + bs);
                u32x2 w; w.x = cvt_pk_bf16(r0, r1); w.y = cvt_pk_bf16(r2, r3);
                *(u32x2*)(MIX + tok * 1024 + 512 + cc) = w; }
        }
        __syncthreads();
    }
}
__device__ void phase_convert_wsp(KP p, int wv) {
    asm volatile("" : "+s"(p));
    const float4* src = (const float4*)p->in[9]; u32x2* dst = (u32x2*)(p->ws + WS_AC + 524288);
    for (int i = blockIdx.x * 512 + otid(wv); i < DEPTH * 4 * 128 * 128 / 4; i += gridDim.x * 512) { const float4 v = src[i]; u32x2 w; w.x = cvt_pk_bf16(v.x, v.y); w.y = cvt_pk_bf16(v.z, v.w); dst[i] = w; }
}

#define XB_TMO      128
#define XB_XCNT(j)  (256  + 64 * (j))
#define XB_XSUB(j)  (1280 + 64 * (j))
#define XB_XGEN(j)  (2304 + 64 * (j))
#define XB_TOP      3328
#define XB_TOPGEN   3392
#define XCD_BAR_WORDS 3456
#define XB_SPIN_CAP (1u << 22)
__device__ __forceinline__ unsigned xb_ld(unsigned* p)              { return __hip_atomic_load(p, __ATOMIC_RELAXED, __HIP_MEMORY_SCOPE_AGENT); }
__device__ __forceinline__ unsigned xb_add(unsigned* p, unsigned v) { return __hip_atomic_fetch_add(p, v, __ATOMIC_RELAXED, __HIP_MEMORY_SCOPE_AGENT); }
__device__ __forceinline__ unsigned xb_xcc_id() { return (unsigned)__builtin_amdgcn_s_getreg((3 << 11) | 20) & 0xFu; }
#define XB_SPIN(cond, bar) do { unsigned _sp = 0; while (cond) { __builtin_amdgcn_s_sleep(1); \
    if ((++_sp & 255u) == 0u) { if (xb_ld(&(bar)[XB_TMO])) break; if (_sp > XB_SPIN_CAP) { atomicAdd(&(bar)[XB_TMO], 1u); break; } } } } while (0)
struct XcdBarrier { unsigned* bar; unsigned x; volatile LAS unsigned* st; };
__device__ __forceinline__ XcdBarrier xcd_barrier_post(unsigned* bar, volatile LAS unsigned* st) {
    XcdBarrier b; b.bar = bar; b.x = xb_xcc_id(); b.st = st;
    if (threadIdx.x == 0) (void)xb_add(&bar[XB_XCNT(b.x)], 1u);
    return b;
}
__device__ __forceinline__ void xcd_barrier_complete(unsigned* bar, unsigned x, unsigned& nloc, unsigned& nx) {
    const unsigned G = gridDim.x * gridDim.y * gridDim.z;
    unsigned sum, cnt, mine, sp = 0u;
    for (;;) {
        sum = 0u; cnt = 0u; mine = 0u;
#pragma unroll
        for (unsigned j = 0; j < 16; ++j) { const unsigned c = xb_ld(&bar[XB_XCNT(j)]); sum += c; cnt += (c > 0u) ? 1u : 0u; mine = (j == x) ? c : mine; }
        if (sum == G) break;
        __builtin_amdgcn_s_sleep(1);
        if ((++sp & 255u) == 0u) { if (xb_ld(&bar[XB_TMO])) break; if (sp > XB_SPIN_CAP) { atomicAdd(&bar[XB_TMO], 1u); break; } }
    }
    nloc = mine > 0u ? mine : 1u; nx = cnt > 0u ? cnt : 1u;
}
__device__ __forceinline__ void xcd_barrier(const XcdBarrier& b, const int tid) {
    asm volatile("s_waitcnt vmcnt(0)" ::: "memory");
    __syncthreads();
    if (tid == 0) {
        unsigned* bar = b.bar;
        __builtin_amdgcn_s_waitcnt(0);
        unsigned nloc = b.st[0], nx = b.st[1];
        if (nloc == 0u) { xcd_barrier_complete(bar, b.x, nloc, nx); b.st[0] = nloc; b.st[1] = nx; }
        const unsigned old = xb_add(&bar[XB_XSUB(b.x)], 1u);
        const unsigned gen = old / nloc;
        if (old + 1u == (gen + 1u) * nloc) {
            __builtin_amdgcn_fence(__ATOMIC_RELEASE, "agent");
            asm volatile("s_waitcnt vmcnt(0)" ::: "memory");
            const unsigned og = xb_add(&bar[XB_TOP], 1u);
            const unsigned tg = og / nx;
            __builtin_amdgcn_fence(__ATOMIC_ACQUIRE, "agent");
            if (og + 1u == (tg + 1u) * nx) xb_add(&bar[XB_TOPGEN], 1u);
            else XB_SPIN(xb_ld(&bar[XB_TOPGEN]) == tg, bar);
            xb_add(&bar[XB_XGEN(b.x)], 1u);
            asm volatile("s_waitcnt vmcnt(0)" ::: "memory");
        } else {
            __builtin_amdgcn_fence(__ATOMIC_ACQUIRE, "agent");
            XB_SPIN(xb_ld(&bar[XB_XGEN(b.x)]) == gen, bar);
            asm volatile("s_waitcnt vmcnt(0)" ::: "memory");
        }
    }
    __syncthreads();
}

__global__ void __launch_bounds__(512) fwd_megakernel(Params p_unused) {
    KP p = (KP)__builtin_amdgcn_kernarg_segment_ptr();
    extern __shared__ __attribute__((aligned(16))) unsigned char shm[];
    cg::grid_group grid = cg::this_grid();
    LAS unsigned char* lds = (LAS unsigned char*)shm; float* smf = (float*)shm;
    const int G = gridDim.x, c = blockIdx.x;
    volatile LAS unsigned* xbw = (volatile LAS unsigned*)(lds + LDS_MAIN);
    if (threadIdx.x < 4) xbw[threadIdx.x] = 0u;
    __syncthreads();
    const XcdBarrier xbar = xcd_barrier_post((unsigned*)(fresh(p)->ws + WS_BAR), xbw);
const int wv = __builtin_amdgcn_readfirstlane(threadIdx.x >> 6);
#define GSYNC() do { xcd_barrier(xbar, otid(wv)); if (PROBE & 16) xcd_barrier(xbar, otid(wv)); } while (0)
    bf16_t* W = (bf16_t*)(fresh(p)->ws + WS_W); bf16_t* KB = (bf16_t*)(fresh(p)->ws + WS_K); bf16_t* VT = (bf16_t*)(fresh(p)->ws + WS_VT);
    bf16_t* XN = (bf16_t*)(fresh(p)->ws + WS_XN); bf16_t* Hb = (bf16_t*)(fresh(p)->ws + WS_H); bf16_t* Yb = (bf16_t*)(fresh(p)->ws + WS_Y);
    bf16_t* MEMN = (bf16_t*)(fresh(p)->ws + WS_MEMN);
    float* RS = (float*)(fresh(p)->ws + WS_BAR + 65536);

    for (int rep = 0; rep < ((PROBE & 4) ? 2 : 1); ++rep) phase_convert_weights(fresh(p), smf, wv);
    phase_convert_wsp(fresh(p), wv);
    phase_x_init(fresh(p)->in[0], (bf16_t*)fresh(p)->out, RS, wv);
    for (int l = 0; l < DEPTH; ++l) rms_rows_bf16(fresh(p)->in[1], fresh(p)->in[14] + (size_t)l * 1024, MEMN + (size_t)l * 2048 * 1024, BATCH * NMEM, wv);
    GSYNC();
    if (fresh(p)->ws == nullptr) grid.sync();

    for (int l = 0; l < DEPTH; ++l) {
        const bf16_t* wl = W + (size_t)l * WL_SZ;
        for (int rep = 0; rep < ((PROBE & 1) ? 2 : 1); ++rep) { pg8::SchedInKV S{(const bf16_t*)fresh(p)->out, wl + WIN_O, MEMN + (size_t)l * 2048 * 1024, wl + WXKV_O, l, G, c}; pg8::EpiBf16 E{(bf16_t*)fresh(p)->ws, RS}; pg8::gemm_phase<1024, 1024, 1024>(lds, S, E, wv); }
        GSYNC();
        for (int rep = 0; rep < ((PROBE & 2) ? 2 : 1); ++rep) phase_gla_chunk(fresh(p), l, lds, wv);
        GSYNC();
        for (int step = 0; step < 2; ++step) { if ((step ^ ((c >> 3) & 1)) == 0) phase_gla_scan(fresh(p), wv); else phase_sg(fresh(p), l, lds, wv); }
        GSYNC();
        for (int rep = 0; rep < ((PROBE & 2) ? 2 : 1); ++rep) phase_gla_out(fresh(p), l, lds, wv);
        GSYNC();
        for (int rep = 0; rep < ((PROBE & 1) ? 2 : 1); ++rep) { pg8::SchedStd<0> S{XN, wl + WOUT_O, 128, 4, 1024, 1024, 1024, G, c}; pg8::EpiBf16 E{Yb}; pg8::gemm_phase<1024, 1024, 1024>(lds, S, E, wv); }
        GSYNC();
        phase_norm_res<true, true>(Yb, fresh(p)->out, fresh(p)->out, fresh(p)->in[12] + (size_t)l * 1024, RS, wv);
        GSYNC();
        #define LOCAL_SEAM() do { asm volatile("s_waitcnt vmcnt(0)" ::: "memory"); __syncthreads(); } while (0)
        for (int rep = 0; rep < ((PROBE & 1) ? 2 : 1); ++rep) { pg8::SchedAttn<2> S{(const bf16_t*)fresh(p)->out, wl + WXQ_O, G, c}; pg8::EpiBf16 E{Yb, RS}; pg8::gemm_phase<1024, 1024, 1024>(lds, S, E, wv); }
        LOCAL_SEAM();
        for (int rep = 0; rep < ((PROBE & 1) ? 2 : 1); ++rep) { pg8::SchedAttn<0> S{Yb, KB + (size_t)l * 2048 * 1024, G, c}; pg8::EpiSoftmax E{Hb, 0.0625f * 1.4426950408889634f, (LAS float*)(lds + pg8::STAGE_BYTES)}; pg8::gemm_phase<1024, 1024, 256>(lds, S, E, wv); }
        LOCAL_SEAM();
        for (int rep = 0; rep < ((PROBE & 1) ? 2 : 1); ++rep) { pg8::SchedAttn<1> S{Hb, VT + (size_t)l * 8 * 1024 * 256, G, c}; pg8::EpiBf16 E{Yb}; pg8::gemm_phase<1024, 256, 256>(lds, S, E, wv); }
        GSYNC();
        for (int rep = 0; rep < ((PROBE & 1) ? 2 : 1); ++rep) { pg8::SchedStd<0> S{Yb, wl + WXO_O, 128, 4, 1024, 1024, 1024, G, c}; pg8::EpiBf16 E{Hb}; pg8::gemm_phase<1024, 1024, 1024>(lds, S, E, wv); }
        GSYNC();
        phase_norm_res<true, true>(Hb, fresh(p)->out, l + 1 < DEPTH ? (void*)fresh(p)->out : (void*)W, fresh(p)->in[18] + (size_t)l * 1024, RS, wv);
        GSYNC();
        for (int rep = 0; rep < ((PROBE & 1) ? 2 : 1); ++rep) { pg8::SchedStd<1> S{l + 1 < DEPTH ? (const bf16_t*)fresh(p)->out : (const bf16_t*)W, wl + WGU_O, 128, 22, 1024, 1024, DFF, G, c}; pg8::EpiSwiglu E{Hb, RS}; pg8::gemm_phase<1024, 1024, 1024>(lds, S, E, wv); }
        GSYNC();
        for (int rep = 0; rep < ((PROBE & 1) ? 2 : 1); ++rep) { pg8::SchedStd<0> S{Hb, wl + WDN_O, 128, 4, DFF, DFF, 1024, G, c}; pg8::EpiBf16 E{Yb}; pg8::gemm_phase<DFF, DFF, DFF>(lds, S, E, wv); }
        GSYNC();
        if (l + 1 < DEPTH) phase_norm_res<true, true>(Yb, fresh(p)->out, fresh(p)->out, fresh(p)->in[22] + (size_t)l * 1024, RS, wv);
        else phase_norm_res<true, false>(Yb, (const void*)W, fresh(p)->out, fresh(p)->in[22] + (size_t)l * 1024, nullptr, wv);
        if (l + 1 < DEPTH) GSYNC();
    }
}

extern "C" void kernel_launch(void* const* d_in, const int* in_sizes, int n_in, void* d_out, int out_size, void* d_ws, size_t ws_size, hipStream_t stream) {
    static int grid_blocks = 0;
    if (grid_blocks == 0) {
        if (n_in != 23 || ws_size < WS_END) { fprintf(stderr, "kernel_launch: unexpected n_in %d / ws_size %zu\n", n_in, ws_size); grid_blocks = -1; return; }
        int dev = 0, cus = 0, per_cu = 0;
        hipGetDevice(&dev);
        hipDeviceGetAttribute(&cus, hipDeviceAttributeMultiprocessorCount, dev);
        if (hipFuncSetAttribute((const void*)fwd_megakernel, hipFuncAttributeMaxDynamicSharedMemorySize, LDS_BYTES) != hipSuccess) { fprintf(stderr, "kernel_launch: hipFuncSetAttribute failed\n"); grid_blocks = -1; return; }
        if (hipOccupancyMaxActiveBlocksPerMultiprocessor(&per_cu, (const void*)fwd_megakernel, 512, LDS_BYTES) != hipSuccess || per_cu < 1) { fprintf(stderr, "kernel_launch: occupancy query failed (%d)\n", per_cu); (void)hipGetLastError(); per_cu = 1; }
        grid_blocks = cus * 1;
        fprintf(stderr, "kernel_launch: cus %d per_cu %d grid %d\n", cus, per_cu, grid_blocks);
    }
    if (grid_blocks < 0) return;
    if (hipMemsetAsync((char*)d_ws + WS_BAR, 0, XCD_BAR_WORDS * 4, stream) != hipSuccess) { fprintf(stderr, "kernel_launch: memset of barrier words failed\n"); return; }
    Params p{};
    for (int i = 0; i < 23; ++i) p.in[i] = (const float*)d_in[i];
    p.out = (float*)d_out; p.ws = (unsigned char*)d_ws;
    void* args[] = {&p};
    hipError_t e = hipLaunchCooperativeKernel((const void*)fwd_megakernel, dim3(grid_blocks), dim3(512), args, LDS_BYTES, stream);
    if (e != hipSuccess) fprintf(stderr, "cooperative launch failed: %s (grid %d)\n", hipGetErrorString(e), grid_blocks);
}
```

```cpp
#include <hip/hip_runtime.h>
#include <hip/hip_cooperative_groups.h>
#include <cstdio>
namespace cg = cooperative_groups;

#define LAS __attribute__((address_space(3)))
typedef unsigned short bf16_t;
typedef short bf16x8 __attribute__((ext_vector_type(8)));
typedef float f32x4 __attribute__((ext_vector_type(4)));
typedef unsigned u32x4 __attribute__((ext_vector_type(4)));
typedef unsigned u32x2 __attribute__((ext_vector_type(2)));

constexpr int BATCH = 8, SEQ = 4096, DM = 1024, MTOK = BATCH * SEQ, NMEM = 256, DEPTH = 4;
constexpr int DIN = 2576, DINP = 2816, DFF = 2816;
constexpr int OFF_Q = 0, OFF_K = 256, OFF_V = 512, OFF_G = 1024, OFF_A = 1536, OFF_U = 1552, OFF_SV = 2064;
constexpr float EPS = 1e-6f;
constexpr int PROBE = 0;

constexpr size_t WIN_O = 0, WOUT_O = 2883584, WXQ_O = 3932160, WXKV_O = 4980736, WXO_O = 7077888, WGU_O = 8126464, WDN_O = 13893632, WL_SZ = 16777216;
constexpr size_t MiB = 1048576;
constexpr size_t WS_W = 0, WS_K = 128 * MiB, WS_VT = 144 * MiB, WS_XN = 160 * MiB, WS_H = 224 * MiB, WS_Y = 400 * MiB, WS_AC = 464 * MiB, WS_BAR = 465 * MiB, WS_MEMN = 466 * MiB, WS_END = 482 * MiB;

constexpr int LDS_MAIN = 139264, LDS_BYTES = LDS_MAIN + 16;

struct Params {
    const float* in[23];
    float* out;
    unsigned char* ws;
};
typedef const __attribute__((address_space(4))) Params* KP;
__device__ __forceinline__ KP fresh(KP k) { asm volatile("" : "+s"(k)); return k; }

typedef __bf16 bf16v2 __attribute__((ext_vector_type(2)));
typedef float f32v2 __attribute__((ext_vector_type(2)));
__device__ __forceinline__ unsigned cvt_pk_bf16(float lo, float hi) { const f32v2 f = {lo, hi}; return __builtin_bit_cast(unsigned, __builtin_convertvector(f, bf16v2)); }
__device__ __forceinline__ int otid(int wv) { int t; asm volatile("v_mbcnt_lo_u32_b32 %0, -1, 0\n\tv_mbcnt_hi_u32_b32 %0, -1, %0\n\tv_lshl_add_u32 %0, %1, 6, %0" : "=&v"(t) : "s"(wv)); return t; }
__device__ __forceinline__ float bf_lo(unsigned w) { return __uint_as_float(w << 16); }
__device__ __forceinline__ float bf_hi(unsigned w) { return __uint_as_float(w & 0xffff0000u); }
__device__ __forceinline__ float bf2f(bf16_t b) { return __uint_as_float(((unsigned)b) << 16); }
__device__ __forceinline__ float shx(float v, int m, int lane) { return __int_as_float(__builtin_amdgcn_ds_bpermute((lane ^ m) << 2, __float_as_int(v))); }
#define DPP_ADD(v, ctrl, rmask) ((v) + __int_as_float(__builtin_amdgcn_update_dpp(0, __float_as_int(v), (ctrl), (rmask), 0xf, false)))
__device__ __forceinline__ float row8_sum(float v) { v = DPP_ADD(v, 0xB1, 0xf); v = DPP_ADD(v, 0x4E, 0xf); v = DPP_ADD(v, 0x141, 0xf); return v; }
__device__ __forceinline__ float wave_sum(float v, int) {
    v = row8_sum(v); v = DPP_ADD(v, 0x140, 0xf); v = DPP_ADD(v, 0x142, 0xa); v = DPP_ADD(v, 0x143, 0xc);
    return __int_as_float(__builtin_amdgcn_readlane(__float_as_int(v), 63));
}
__device__ __forceinline__ float gelu_tanh(float x) {
    const float y2 = 1.5957691216057308f * (x + 0.044715f * x * x * x);
    return x * __builtin_amdgcn_rcpf(1.0f + __expf(-y2));
}
__device__ __forceinline__ float silu_f(float x) { return x * __builtin_amdgcn_rcpf(1.0f + __expf(-x)); }
__device__ __forceinline__ float logsigmoid_f(float z) { return fminf(z, 0.0f) - __logf(1.0f + __expf(-fabsf(z))); }

namespace pg8 {
constexpr int BM = 256, BK = 64, HALF = 128, HTB = HALF * BK * 2, STAGE_BYTES = 8 * HTB, NXCD = 8, WGM = 8;
__device__ __forceinline__ int lds_byte(int r, int c) { const int st = (r >> 4) * 2 + (c >> 5), rr = r & 15, cc = c & 31, ob = rr * 64 + cc * 2; return st * 1024 + (ob ^ (((ob >> 9) & 1) << 5)); }
__device__ __forceinline__ void stage_rc(int b, int& R, int& C) { const int st = b / 1024, sb = b % 1024, swz = sb ^ (((sb >> 9) & 1) << 5); R = (st >> 1) * 16 + swz / 64; C = (st & 1) * 32 + (swz % 64) / 2; }
__device__ __forceinline__ int perm32(int rho) { const int n = rho >> 4, i = rho & 15; return 8 * (i >> 2) + 4 * n + (i & 3); }

struct Unit { const char* a; const char* b; size_t o; int ldc; int row0; };

__device__ __forceinline__ bool std_tile(int i, int G, int c, int nM, int nN, int& pm, int& pn) {
    const int nwg = nM * nN; const long L = (long)i * G + c; if (L >= nwg) return false;
    int wgid = (int)L; { const int q = nwg / NXCD, r = nwg % NXCD, xcd = wgid % NXCD, off = wgid / NXCD; wgid = (xcd < r ? xcd * (q + 1) : r * (q + 1) + (xcd - r) * q) + off; }
    const int nig = WGM * nN, gid = wgid / nig, fm = gid * WGM, gsz = (nM - fm) < WGM ? (nM - fm) : WGM;
    pm = fm + ((wgid % nig) % gsz); pn = (wgid % nig) / gsz; return true;
}
template <int MODE> struct SchedStd {
    const bf16_t* A; const bf16_t* Bt; int nM, nN, lda, ldb, ldc, G, c;
    __device__ __forceinline__ bool next(int i, Unit& u) const {
        int pm, pn; if (!std_tile(i, G, c, nM, nN, pm, pn)) return false;
        u.a = (const char*)(A + (size_t)pm * 256 * lda); u.b = (const char*)(Bt + (size_t)pn * 256 * ldb);
        u.o = (size_t)pm * 256 * ldc + (size_t)pn * (MODE == 1 ? 128 : 256); u.ldc = ldc; u.row0 = pm * 256; return true;
    }
};
struct SchedInKV {
    const bf16_t* A; const bf16_t* Bt; const bf16_t* memn; const bf16_t* Wkv; int l, G, c;
    __device__ __forceinline__ bool next(int i, Unit& u) const {
        int pm, pn;
        if (std_tile(i, G, c, 128, 11, pm, pn)) { u.a = (const char*)(A + (size_t)pm * 256 * 1024); u.b = (const char*)(Bt + (size_t)pn * 256 * 1024);
            u.o = WS_H / 2 + (size_t)pm * 256 * DINP + (size_t)pn * 256; u.ldc = DINP; u.row0 = pm * 256; return true; }
        const long r = (long)i * G + c - 1408; if (r >= 64) return false;
        u.row0 = -1;
        if (r < 32) { const int b = (int)r >> 2, pn2 = (int)r & 3; u.a = (const char*)(memn + (size_t)b * 256 * 1024); u.b = (const char*)(Wkv + (size_t)pn2 * 256 * 1024);
            u.o = WS_K / 2 + ((size_t)l * 2048 + b * 256) * 1024 + pn2 * 256; u.ldc = 1024; }
        else { const int rr = (int)r - 32, pm2 = rr >> 3, b = rr & 7; u.a = (const char*)(Wkv + (size_t)(1024 + pm2 * 256) * 1024); u.b = (const char*)(memn + (size_t)b * 256 * 1024);
            u.o = WS_VT / 2 + (((size_t)l * 8 + b) * 1024 + pm2 * 256) * 256; u.ldc = 256; }
        return true;
    }
};
struct SchedKV {
    const bf16_t* memn; const bf16_t* W; size_t kbase, vbase; int G, c;
    __device__ __forceinline__ bool next(int i, Unit& u) const {
        const long L = (long)i * G + c; if (L >= 256) return false;
        const int l = (int)L >> 6, r = (int)L & 63; const bf16_t* wl = W + (size_t)l * WL_SZ + WXKV_O; const bf16_t* ml = memn + (size_t)l * 2048 * 1024;
        if (r < 32) { const int b = r >> 2, pn = r & 3; u.a = (const char*)(ml + (size_t)b * 256 * 1024); u.b = (const char*)(wl + (size_t)pn * 256 * 1024);
            u.o = kbase + ((size_t)l * 2048 + b * 256) * 1024 + pn * 256; u.ldc = 1024; u.row0 = 0; }
        else { const int rr = r - 32, pm = rr >> 3, b = rr & 7; u.a = (const char*)(wl + (size_t)(1024 + pm * 256) * 1024); u.b = (const char*)(ml + (size_t)b * 256 * 1024);
            u.o = vbase + (((size_t)l * 8 + b) * 1024 + pm * 256) * 256; u.ldc = 256; u.row0 = 0; }
        return true;
    }
};
template <int MODE> struct SchedAttn {
    const bf16_t* A; const bf16_t* Bm; int G, c;
    __device__ __forceinline__ bool next(int i, Unit& u) const {
        const long L = (long)i * G + c; if (L >= 512) return false;
        int pm = (int)L >> 2, h = (int)L & 3;
        if (G == 256) { pm = i * 64 + (c & 7) * 8 + (c >> 5); h = (c >> 3) & 3; }
        const int b = pm >> 4;
        u.a = (const char*)(A + (size_t)pm * 256 * 1024 + (MODE == 2 ? 0 : h * 256));
        u.b = MODE == 0 ? (const char*)(Bm + (size_t)b * 256 * 1024 + h * 256) : (MODE == 1 ? (const char*)(Bm + ((size_t)b * 1024 + h * 256) * 256) : (const char*)(Bm + (size_t)h * 256 * 1024));
        u.o = (size_t)pm * 256 * 1024 + h * 256; u.ldc = 1024; u.row0 = pm * 256; return true;
    }
};

struct EpiBf16 {
    static constexpr bool PERM = true, RSLDS = true; bf16_t* O; const float* rs = nullptr;
    __device__ __forceinline__ void operator()(const f32x4 (&acc)[2][2][4][2], const Unit& u, int wr, int wc, int fr, int fq, const LAS float* lrs) const {
        bf16_t* base = O + u.o + (size_t)(wr * 64 + fr) * u.ldc + wc * 32 + 8 * fq;
#pragma unroll
        for (int ai = 0; ai < 2; ++ai)
#pragma unroll
            for (int m = 0; m < 4; ++m) { bf16_t* rowp = base + (size_t)(ai * HALF + m * 16) * u.ldc; const float sc = (rs && u.row0 >= 0) ? lrs[ai * HALF + wr * 64 + m * 16 + fr] : 1.0f;
#pragma unroll
                for (int bj = 0; bj < 2; ++bj) { const f32x4 v0 = acc[ai][bj][m][0] * sc, v1 = acc[ai][bj][m][1] * sc;
                    u32x4 w; w.x = cvt_pk_bf16(v0[0], v0[1]); w.y = cvt_pk_bf16(v0[2], v0[3]); w.z = cvt_pk_bf16(v1[0], v1[1]); w.w = cvt_pk_bf16(v1[2], v1[3]);
                    *(u32x4*)(rowp + bj * HALF) = w; } }
    }
};
struct EpiSwiglu {
    static constexpr bool PERM = true, RSLDS = true; bf16_t* O; const float* rs;
    __device__ __forceinline__ void operator()(const f32x4 (&acc)[2][2][4][2], const Unit& u, int wr, int wc, int fr, int fq, const LAS float* lrs) const {
        bf16_t* base = O + u.o + (size_t)(wr * 64 + fr) * u.ldc + wc * 32 + 8 * fq;
#pragma unroll
        for (int ai = 0; ai < 2; ++ai)
#pragma unroll
            for (int m = 0; m < 4; ++m) { bf16_t* rowp = base + (size_t)(ai * HALF + m * 16) * u.ldc; const float sc = lrs[ai * HALF + wr * 64 + m * 16 + fr];
                float r[8];
#pragma unroll
                for (int n = 0; n < 2; ++n)
#pragma unroll
                    for (int e = 0; e < 4; ++e) r[n * 4 + e] = silu_f(acc[ai][0][m][n][e] * sc) * (acc[ai][1][m][n][e] * sc);
                u32x4 w; w.x = cvt_pk_bf16(r[0], r[1]); w.y = cvt_pk_bf16(r[2], r[3]); w.z = cvt_pk_bf16(r[4], r[5]); w.w = cvt_pk_bf16(r[6], r[7]);
                *(u32x4*)rowp = w; }
    }
};
struct EpiSoftmax {
    static constexpr bool PERM = true, RSLDS = false; bf16_t* O; float scale2; LAS float* st;
    __device__ __forceinline__ void operator()(f32x4 (&acc)[2][2][4][2], const Unit& u, int wr, int wc, int fr, int fq, const LAS float*) const {
#pragma unroll
        for (int ai = 0; ai < 2; ++ai)
#pragma unroll
            for (int m = 0; m < 4; ++m) { float mx = -3.0e38f;
#pragma unroll
                for (int bj = 0; bj < 2; ++bj)
#pragma unroll
                    for (int n = 0; n < 2; ++n)
#pragma unroll
                        for (int e = 0; e < 4; ++e) mx = fmaxf(mx, acc[ai][bj][m][n][e]);
                mx = fmaxf(mx, shx(mx, 16, fq * 16 + fr)); mx = fmaxf(mx, shx(mx, 32, fq * 16 + fr));
                if (fq == 0) st[(ai * HALF + wr * 64 + m * 16 + fr) * 4 + wc] = mx; }
        asm volatile("s_waitcnt lgkmcnt(0)" ::: "memory"); __builtin_amdgcn_s_barrier(); asm volatile("" ::: "memory");
#pragma unroll
        for (int ai = 0; ai < 2; ++ai)
#pragma unroll
            for (int m = 0; m < 4; ++m) { const int row = ai * HALF + wr * 64 + m * 16 + fr; const f32x4 m4 = *(const LAS f32x4*)(st + row * 4);
                const float mx = fmaxf(fmaxf(m4[0], m4[1]), fmaxf(m4[2], m4[3])); float sm = 0.f;
#pragma unroll
                for (int bj = 0; bj < 2; ++bj)
#pragma unroll
                    for (int n = 0; n < 2; ++n)
#pragma unroll
                        for (int e = 0; e < 4; ++e) { const float ex = __builtin_amdgcn_exp2f((acc[ai][bj][m][n][e] - mx) * scale2); acc[ai][bj][m][n][e] = ex; sm += ex; }
                sm += shx(sm, 16, fq * 16 + fr); sm += shx(sm, 32, fq * 16 + fr);
                if (fq == 0) st[1024 + row * 4 + wc] = sm; }
        asm volatile("s_waitcnt lgkmcnt(0)" ::: "memory"); __builtin_amdgcn_s_barrier(); asm volatile("" ::: "memory");
        bf16_t* base = O + u.o + (size_t)(wr * 64 + fr) * u.ldc + wc * 32 + 8 * fq;
#pragma unroll
        for (int ai = 0; ai < 2; ++ai)
#pragma unroll
            for (int m = 0; m < 4; ++m) { const int row = ai * HALF + wr * 64 + m * 16 + fr; const f32x4 s4 = *(const LAS f32x4*)(st + 1024 + row * 4);
                const float inv = 1.0f / ((s4[0] + s4[1]) + (s4[2] + s4[3])); bf16_t* rowp = base + (size_t)(ai * HALF + m * 16) * u.ldc;
#pragma unroll
                for (int bj = 0; bj < 2; ++bj) { const f32x4 v0 = acc[ai][bj][m][0] * inv, v1 = acc[ai][bj][m][1] * inv;
                    u32x4 w; w.x = cvt_pk_bf16(v0[0], v0[1]); w.y = cvt_pk_bf16(v0[2], v0[3]); w.z = cvt_pk_bf16(v1[0], v1[1]); w.w = cvt_pk_bf16(v1[2], v1[3]);
                    *(u32x4*)(rowp + bj * HALF) = w; } }
    }
};
struct EpiF32Scale {
    static constexpr bool PERM = false, RSLDS = false; float* O; float scale;
    __device__ __forceinline__ void operator()(const f32x4 (&acc)[2][2][4][2], const Unit& u, int wr, int wc, int fr, int fq, const LAS float*) const {
        float* base = O + u.o + (size_t)(wr * 64 + fr) * u.ldc + wc * 32 + 4 * fq;
#pragma unroll
        for (int ai = 0; ai < 2; ++ai)
#pragma unroll
            for (int m = 0; m < 4; ++m) { float* rowp = base + (size_t)(ai * HALF + m * 16) * u.ldc;
#pragma unroll
                for (int bj = 0; bj < 2; ++bj)
#pragma unroll
                    for (int n = 0; n < 2; ++n) *(f32x4*)(rowp + bj * HALF + n * 16) = acc[ai][bj][m][n] * scale; }
    }
};

template <int lda, int ldb, int K, class Epi, class Sched>
__device__ __forceinline__ void gemm_phase(LAS unsigned char* lds, const Sched& S, const Epi& E, const int wv) {
    const int tid = otid(wv), wid = __builtin_amdgcn_readfirstlane(tid >> 6), lane = tid & 63, wr = wid >> 2, wc = wid & 3, fr = lane & 15, fq = lane >> 4;
    const int nt = K / BK;
    unsigned voffA[2], voffB[2];
#pragma unroll
    for (int i = 0; i < 2; ++i) { int R, C; stage_rc(tid * 16 + i * 8192, R, C); const int Rb = Epi::PERM ? ((R & ~31) + perm32(R & 31)) : R;
        voffA[i] = (unsigned)(R * lda + C) * 2u; voffB[i] = (unsigned)(Rb * ldb + C) * 2u; }
    const size_t kstep = (size_t)(BK * 2);
    const size_t hstepA = (size_t)HALF * lda * 2, hstepB = (size_t)HALF * ldb * 2;
    const unsigned ldsw = (unsigned)wid * 1024u;
    const int aoff = lds_byte(wr * 64 + fr, fq * 8), boff = lds_byte(wc * 32 + fr, fq * 8);
#define PG8_SA(b, h) (((b) * 2 + (h)) * HTB)
#define PG8_SB(b, h) ((4 + (b) * 2 + (h)) * HTB)
#define PG8_STAGE(bufoff, gbase, voff) do { _Pragma("unroll") for (int _i = 0; _i < 2; ++_i) \
        __builtin_amdgcn_global_load_lds((const unsigned*)((const char*)(gbase) + (voff)[_i]), (LAS unsigned*)(lds + (bufoff) + ldsw + _i * 8192), 16, 0, 0); } while (0)
#define PG8_LDA(dst, b, h) do { _Pragma("unroll") for (int m = 0; m < 4; ++m) _Pragma("unroll") for (int k = 0; k < 2; ++k) dst[m][k] = *(const LAS bf16x8*)(lds + PG8_SA(b, h) + aoff + m * 2048 + k * 1024); } while (0)
#define PG8_LDB(dst, b, h) do { _Pragma("unroll") for (int n = 0; n < 2; ++n) _Pragma("unroll") for (int k = 0; k < 2; ++k) dst[n][k] = *(const LAS bf16x8*)(lds + PG8_SB(b, h) + boff + n * 2048 + k * 1024); } while (0)
#define PG8_MMA(ai, bj, At, Bt) do { __builtin_amdgcn_s_setprio(1); _Pragma("unroll") for (int m = 0; m < 4; ++m) _Pragma("unroll") for (int n = 0; n < 2; ++n) _Pragma("unroll") for (int k = 0; k < 2; ++k) \
        acc[ai][bj][m][n] = __builtin_amdgcn_mfma_f32_16x16x32_bf16(Bt[n][k], At[m][k], acc[ai][bj][m][n], 0, 0, 0); __builtin_amdgcn_s_setprio(0); } while (0)
#define PG8_WAIT_V(n) asm volatile("s_waitcnt vmcnt(" #n ")" ::: "memory")
#define PG8_WAIT_L(n) asm volatile("s_waitcnt lgkmcnt(" #n ")" ::: "memory")
#define PG8_BAR __builtin_amdgcn_s_barrier()
#define PG8_SCHED __builtin_amdgcn_sched_barrier(0)
    Unit cur, nxt; int ui = 0;
    if (!S.next(0, cur)) return;
    const char* cA = cur.a; const char* cB = cur.b;
    f32x4 acc[2][2][4][2];
#pragma unroll
    for (int a = 0; a < 2; ++a)
#pragma unroll
        for (int b = 0; b < 2; ++b)
#pragma unroll
            for (int m = 0; m < 4; ++m)
#pragma unroll
                for (int n = 0; n < 2; ++n) acc[a][b][m][n] = (f32x4){0.f, 0.f, 0.f, 0.f};
    bf16x8 At[4][2], B0[2][2], B1[2][2];
    PG8_STAGE(PG8_SB(0, 0), cB, voffB); PG8_STAGE(PG8_SB(0, 1), cB + hstepB, voffB); PG8_STAGE(PG8_SA(0, 0), cA, voffA); PG8_STAGE(PG8_SA(0, 1), cA + hstepA, voffA);
    if (wr == 1) PG8_BAR;
    PG8_WAIT_V(2); PG8_BAR;
    PG8_STAGE(PG8_SB(1, 0), cB + kstep, voffB); PG8_STAGE(PG8_SA(1, 0), cA + kstep, voffA); PG8_STAGE(PG8_SB(1, 1), cB + hstepB + kstep, voffB);
    PG8_WAIT_V(6); PG8_BAR;
    for (;;) {
        const bool has_next = S.next(ui + 1, nxt);
        const char* nA = has_next ? nxt.a : cA; const char* nB = has_next ? nxt.b : cB;
#pragma unroll 1
        for (int t = 0; t < nt; t += 2) {
            const bool last = (t == nt - 2);
            if constexpr (Epi::RSLDS) { if (t == 0 && wid < 4 && E.rs != nullptr && cur.row0 >= 0)
                __builtin_amdgcn_global_load_lds((const unsigned*)(E.rs + cur.row0 + wid * 64 + lane), (LAS unsigned*)(lds + STAGE_BYTES + (ui & 1) * 1024 + wid * 256), 4, 0, 0); }
            const char* a1 = cA + (size_t)(t + 1) * kstep;
            const char* a2 = last ? nA : cA + (size_t)(t + 2) * kstep; const char* b2 = last ? nB : cB + (size_t)(t + 2) * kstep;
            const char* a3 = a2 + kstep; const char* b3 = b2 + kstep;
            PG8_LDB(B0, 0, 0); PG8_LDB(B1, 0, 1); PG8_SCHED; PG8_LDA(At, 0, 0); PG8_STAGE(PG8_SA(1, 1), a1 + hstepA, voffA);
            PG8_WAIT_V(8); PG8_WAIT_L(0); PG8_BAR; PG8_MMA(0, 0, At, B0); PG8_MMA(0, 1, At, B1); PG8_BAR; PG8_SCHED;
            PG8_LDA(At, 0, 1); PG8_STAGE(PG8_SB(0, 0), b2, voffB); PG8_STAGE(PG8_SB(0, 1), b2 + hstepB, voffB); PG8_STAGE(PG8_SA(0, 0), a2, voffA);
            PG8_WAIT_V(8); PG8_WAIT_L(0); PG8_BAR; PG8_MMA(1, 0, At, B0); PG8_MMA(1, 1, At, B1); PG8_BAR; PG8_SCHED;
            PG8_LDB(B0, 1, 0); PG8_LDB(B1, 1, 1); PG8_SCHED; PG8_LDA(At, 1, 0); PG8_STAGE(PG8_SA(0, 1), a2 + hstepA, voffA);
            PG8_WAIT_V(8); PG8_WAIT_L(0); PG8_BAR; PG8_MMA(0, 0, At, B0); PG8_MMA(0, 1, At, B1); PG8_BAR; PG8_SCHED;
            PG8_LDA(At, 1, 1); PG8_STAGE(PG8_SB(1, 0), b3, voffB); PG8_STAGE(PG8_SB(1, 1), b3 + hstepB, voffB); PG8_STAGE(PG8_SA(1, 0), a3, voffA);
            PG8_WAIT_V(8); PG8_WAIT_L(0); PG8_BAR; PG8_MMA(1, 0, At, B0); PG8_MMA(1, 1, At, B1); PG8_BAR; PG8_SCHED;
        }
        if (wr == 0) PG8_BAR;
        { const int l2 = otid(wv) & 63; E(acc, cur, wr, wc, l2 & 15, l2 >> 4, (const LAS float*)(lds + STAGE_BYTES + (ui & 1) * 1024)); }
        if (!has_next) break;
#pragma unroll
        for (int a = 0; a < 2; ++a)
#pragma unroll
            for (int b = 0; b < 2; ++b)
#pragma unroll
                for (int m = 0; m < 4; ++m)
#pragma unroll
                    for (int n = 0; n < 2; ++n) acc[a][b][m][n] = (f32x4){0.f, 0.f, 0.f, 0.f};
        cur = nxt; cA = nA; cB = nB; ++ui;
        if (wr == 1) PG8_BAR;
    }
    PG8_WAIT_V(0);
    PG8_BAR;
#undef PG8_SA
#undef PG8_SB
#undef PG8_STAGE
#undef PG8_LDA
#undef PG8_LDB
#undef PG8_MMA
#undef PG8_WAIT_V
#undef PG8_WAIT_L
#undef PG8_BAR
#undef PG8_SCHED
}
}

struct ConvUnit { const float* src; bf16_t* dst; int Nsrc, k0, n0, ldd, drow0; const float* gk; };
__device__ __forceinline__ ConvUnit conv_decode(KP p, int t) {
    bf16_t* W = (bf16_t*)(p->ws + WS_W); const int l = t >> 10, r = t & 1023; bf16_t* wl = W + (size_t)l * WL_SZ; ConvUnit u;
    if (r < 176) { const int tn = r >> 2, kg = r & 3; u = ConvUnit{p->in[3] + (size_t)l * 1024 * DIN, wl + WIN_O, DIN, kg * 256, tn * 64, 1024, tn * 64, p->in[2] + (size_t)l * 1024}; }
    else if (r < 240) { const int q = r - 176, tn = q >> 2, kg = q & 3; u = ConvUnit{p->in[11] + (size_t)l * 1024 * 1024, wl + WOUT_O, 1024, kg * 256, tn * 64, 1024, tn * 64, nullptr}; }
    else if (r < 304) { const int q = r - 240, tn = q >> 2, kg = q & 3; u = ConvUnit{p->in[15] + (size_t)l * 1024 * 1024, wl + WXQ_O, 1024, kg * 256, tn * 64, 1024, tn * 64, p->in[13] + (size_t)l * 1024}; }
    else if (r < 432) { const int q = r - 304, tn = q >> 2, kg = q & 3; u = ConvUnit{p->in[16] + (size_t)l * 1024 * 2048, wl + WXKV_O, 2048, kg * 256, tn * 64, 1024, tn * 64, nullptr}; }
    else if (r < 496) { const int q = r - 432, tn = q >> 2, kg = q & 3; u = ConvUnit{p->in[17] + (size_t)l * 1024 * 1024, wl + WXO_O, 1024, kg * 256, tn * 64, 1024, tn * 64, nullptr}; }
    else if (r < 848) { const int q = r - 496, tn = q >> 2, kg = q & 3; const int n0 = tn * 64, isup = n0 >= DFF, j0 = isup ? n0 - DFF : n0;
        u = ConvUnit{p->in[20] + (size_t)l * 1024 * 2 * DFF, wl + WGU_O, 2 * DFF, kg * 256, n0, 1024, (j0 >> 7) * 256 + (isup ? 128 : 0) + (j0 & 127), p->in[19] + (size_t)l * 1024}; }
    else { const int q = r - 848, tn = q / 11, kg = q % 11; u = ConvUnit{p->in[21] + (size_t)l * DFF * 1024, wl + WDN_O, 1024, kg * 256, tn * 64, DFF, tn * 64, nullptr}; }
    return u;
}
__device__ __forceinline__ void conv_load(const ConvUnit& u, int tid, float4 (&v)[4][2]) {
#pragma unroll
    for (int i = 0; i < 4; ++i) { const int idx = tid + 512 * i, rp = idx >> 4, c4 = (idx & 15) * 4;
#pragma unroll
        for (int h = 0; h < 2; ++h) { const int r = 2 * rp + h; v[i][h] = make_float4(0.f, 0.f, 0.f, 0.f);
            if (u.n0 + c4 < u.Nsrc) { const f32x4 t4 = __builtin_nontemporal_load((const f32x4*)(u.src + (size_t)(u.k0 + r) * u.Nsrc + u.n0 + c4)); const float g = u.gk ? u.gk[u.k0 + r] : 1.0f;
                v[i][h] = make_float4(t4[0] * g, t4[1] * g, t4[2] * g, t4[3] * g); } } }
}
__device__ void phase_convert_weights(KP p, float* sT_, int wv) {
    unsigned* sT = (unsigned*)sT_;
    const int tid = otid(wv); int t = blockIdx.x; if (t >= DEPTH * 1024) return;
    ConvUnit u = conv_decode(p, t); float4 v[4][2]; conv_load(u, tid, v);
    for (;;) {
#pragma unroll
        for (int i = 0; i < 4; ++i) { const int idx = tid + 512 * i, rp = idx >> 4, c4 = (idx & 15) * 4;
            sT[(c4 + 0) * 129 + rp] = cvt_pk_bf16(v[i][0].x, v[i][1].x); sT[(c4 + 1) * 129 + rp] = cvt_pk_bf16(v[i][0].y, v[i][1].y);
            sT[(c4 + 2) * 129 + rp] = cvt_pk_bf16(v[i][0].z, v[i][1].z); sT[(c4 + 3) * 129 + rp] = cvt_pk_bf16(v[i][0].w, v[i][1].w); }
        __syncthreads();
        const ConvUnit cu = u; const int tn = t + gridDim.x; const bool more = tn < DEPTH * 1024;
        if (more) { u = conv_decode(p, tn); conv_load(u, tid, v); }
#pragma unroll
        for (int i = 0; i < 4; ++i) { const int q = tid + 512 * i, nl = q & 63, kc = q >> 6;
            u32x4 w; w.x = sT[nl * 129 + kc * 4]; w.y = sT[nl * 129 + kc * 4 + 1]; w.z = sT[nl * 129 + kc * 4 + 2]; w.w = sT[nl * 129 + kc * 4 + 3];
            *(u32x4*)(cu.dst + (size_t)(cu.drow0 + nl) * cu.ldd + cu.k0 + kc * 8) = w; }
        __syncthreads();
        if (!more) break;
        t = tn;
    }
}
__device__ void rms_rows_bf16(const float* src, const float* g, bf16_t* dst, int nrows, int wv) {
    const int lane = otid(wv) & 63, gw = blockIdx.x * 8 + (otid(wv) >> 6), nw = gridDim.x * 8;
    for (int row0 = gw * 4; row0 < nrows; row0 += nw * 4) {
        float4 v[4][4];
#pragma unroll
        for (int r = 0; r < 4; ++r)
#pragma unroll
            for (int i = 0; i < 4; ++i) v[r][i] = ((const float4*)(src + (size_t)(row0 + r) * 1024))[i * 64 + lane];
#pragma unroll
        for (int r = 0; r < 4; ++r) { float ss = 0.f;
#pragma unroll
            for (int i = 0; i < 4; ++i) ss += v[r][i].x * v[r][i].x + v[r][i].y * v[r][i].y + v[r][i].z * v[r][i].z + v[r][i].w * v[r][i].w;
            ss = wave_sum(ss, lane); const float rs = rsqrtf(ss * (1.0f / 1024.0f) + EPS);
#pragma unroll
            for (int i = 0; i < 4; ++i) { const float4 gg = ((const float4*)g)[i * 64 + lane];
                u32x2 w; w.x = cvt_pk_bf16(v[r][i].x * rs * gg.x, v[r][i].y * rs * gg.y); w.y = cvt_pk_bf16(v[r][i].z * rs * gg.z, v[r][i].w * rs * gg.w);
                *(u32x2*)(dst + (size_t)(row0 + r) * 1024 + i * 256 + lane * 4) = w; } }
    }
}
__device__ void phase_x_init(const float* src, bf16_t* dst, float* rsout, int wv) {
    const int lane = otid(wv) & 63, gw = blockIdx.x * 8 + (otid(wv) >> 6), nw = gridDim.x * 8;
    for (int row0 = gw * 4; row0 < MTOK; row0 += nw * 4) {
        float4 v[4][4];
#pragma unroll
        for (int r = 0; r < 4; ++r)
#pragma unroll
            for (int i = 0; i < 4; ++i) v[r][i] = ((const float4*)(src + (size_t)(row0 + r) * 1024))[i * 64 + lane];
#pragma unroll
        for (int r = 0; r < 4; ++r) { float ss = 0.f;
#pragma unroll
            for (int i = 0; i < 4; ++i) { ss += v[r][i].x * v[r][i].x + v[r][i].y * v[r][i].y + v[r][i].z * v[r][i].z + v[r][i].w * v[r][i].w;
                u32x2 w; w.x = cvt_pk_bf16(v[r][i].x, v[r][i].y); w.y = cvt_pk_bf16(v[r][i].z, v[r][i].w);
                *(u32x2*)(dst + (size_t)(row0 + r) * 1024 + i * 256 + lane * 4) = w; }
            ss = wave_sum(ss, lane); if (lane == 0) rsout[row0 + r] = rsqrtf(ss * (1.0f / 1024.0f) + EPS); }
    }
}
template <bool XIN_BF, bool XOUT_BF>
__device__ void phase_norm_res(const bf16_t* y, const void* xin_, void* xout_, const float* gpost, float* rsout, int wv) {
    const int lane = otid(wv) & 63, gw = blockIdx.x * 8 + (otid(wv) >> 6), nw = gridDim.x * 8;
    for (int row0 = gw * 4; row0 < MTOK; row0 += nw * 4) {
        u32x2 yw[4][4]; float4 xv[4][4];
#pragma unroll
        for (int r = 0; r < 4; ++r)
#pragma unroll
            for (int i = 0; i < 4; ++i) { yw[r][i] = *(const u32x2*)(y + (size_t)(row0 + r) * 1024 + i * 256 + lane * 4);
                if (XIN_BF) { const u32x2 w = *(const u32x2*)((const bf16_t*)xin_ + (size_t)(row0 + r) * 1024 + i * 256 + lane * 4); xv[r][i] = make_float4(bf_lo(w.x), bf_hi(w.x), bf_lo(w.y), bf_hi(w.y)); }
                else xv[r][i] = ((const float4*)((const float*)xin_ + (size_t)(row0 + r) * 1024))[i * 64 + lane]; }
#pragma unroll
        for (int r = 0; r < 4; ++r) { float ss = 0.f; float yv[4][4];
#pragma unroll
            for (int i = 0; i < 4; ++i) { yv[i][0] = bf_lo(yw[r][i].x); yv[i][1] = bf_hi(yw[r][i].x); yv[i][2] = bf_lo(yw[r][i].y); yv[i][3] = bf_hi(yw[r][i].y);
#pragma unroll
                for (int e = 0; e < 4; ++e) ss += yv[i][e] * yv[i][e]; }
            ss = wave_sum(ss, lane); const float rs = rsqrtf(ss * (1.0f / 1024.0f) + EPS); float s2 = 0.f;
#pragma unroll
            for (int i = 0; i < 4; ++i) { const float4 gg = ((const float4*)gpost)[i * 64 + lane]; float4& x = xv[r][i];
                x.x += yv[i][0] * rs * gg.x; x.y += yv[i][1] * rs * gg.y; x.z += yv[i][2] * rs * gg.z; x.w += yv[i][3] * rs * gg.w;
                s2 += x.x * x.x + x.y * x.y + x.z * x.z + x.w * x.w;
                if (XOUT_BF) { u32x2 w; w.x = cvt_pk_bf16(x.x, x.y); w.y = cvt_pk_bf16(x.z, x.w); *(u32x2*)((bf16_t*)xout_ + (size_t)(row0 + r) * 1024 + i * 256 + lane * 4) = w; }
                else ((float4*)((float*)xout_ + (size_t)(row0 + r) * 1024))[i * 64 + lane] = x; }
            if (rsout) { s2 = wave_sum(s2, lane); if (lane == 0) rsout[row0 + r] = rsqrtf(s2 * (1.0f / 1024.0f) + EPS); } }
    }
}
__device__ __forceinline__ bf16x8 pack8(const float (&f)[8]) { u32x4 w; w.x = cvt_pk_bf16(f[0], f[1]); w.y = cvt_pk_bf16(f[2], f[3]); w.z = cvt_pk_bf16(f[4], f[5]); w.w = cvt_pk_bf16(f[6], f[7]); return __builtin_bit_cast(bf16x8, w); }
__device__ __forceinline__ void unpack8(const u32x4 w, float (&f)[8]) { f[0] = bf_lo(w.x); f[1] = bf_hi(w.x); f[2] = bf_lo(w.y); f[3] = bf_hi(w.y); f[4] = bf_lo(w.z); f[5] = bf_hi(w.z); f[6] = bf_lo(w.w); f[7] = bf_hi(w.w); }

__device__ void phase_gla_chunk(KP p, int l, LAS unsigned char* lds, int wv) {
    asm volatile("" : "+s"(p));
    const bf16_t* H = (const bf16_t*)(p->ws + WS_H); bf16_t* UB = (bf16_t*)(p->ws + WS_Y); float* AC = (float*)(p->ws + WS_AC);
    const float* wg = p->in[4] + (size_t)l * 16 * 256; const float* bg = p->in[5] + (size_t)l * 256;
    const int tid = otid(wv), lane = tid & 63, fr = lane & 15, fq = lane >> 4, c = tid & 63, seg = tid >> 6;
    int u = blockIdx.x; if (u >= 2048) return;
    u32x4 aw = (u32x4){0u, 0u, 0u, 0u}; u32x4 vw[2]; bf16_t kn[8];
#define GC_LOAD(uu) do { const int hd_ = (uu) & 3, n_ = ((uu) >> 2) & 63, b_ = (uu) >> 8; const size_t t0_ = (size_t)b_ * SEQ + n_ * 64; \
        if (tid < 128) aw = *(const u32x4*)(H + (t0_ + (tid >> 1)) * DINP + OFF_A + (tid & 1) * 8); \
        _Pragma("unroll") for (int i = 0; i < 2; ++i) { const int idx = tid + 512 * i; vw[i] = *(const u32x4*)(H + (t0_ + (idx & 63)) * DINP + OFF_V + hd_ * 128 + (idx >> 6) * 8); } \
        _Pragma("unroll") for (int i = 0; i < 8; ++i) kn[i] = H[(t0_ + seg * 8 + i) * DINP + OFF_K + hd_ * 64 + c]; } while (0)
    GC_LOAD(u);
    int hd_prev = -1; float wr_[16]; float bgc = 0.f;
#pragma unroll
    for (int r = 0; r < 16; ++r) wr_[r] = 0.f;
    for (int it = 0;; ++it) {
        LAS float* sA = (LAS float*)(lds + (it & 1) * 33792); LAS float* sTot = sA + 1024; LAS bf16_t* kdT = (LAS bf16_t*)(sTot + 512); LAS bf16_t* vT = kdT + 64 * 72;
        const int hd = u & 3;
        if (hd != hd_prev) { hd_prev = hd; bgc = bg[hd * 64 + c];
#pragma unroll
            for (int r = 0; r < 16; ++r) wr_[r] = wg[r * 256 + hd * 64 + c]; }
        if (tid < 128) { float f[8]; unpack8(aw, f); LAS float* d = sA + (tid >> 1) * 16 + (tid & 1) * 8; *(LAS f32x4*)d = (f32x4){f[0], f[1], f[2], f[3]}; *(LAS f32x4*)(d + 4) = (f32x4){f[4], f[5], f[6], f[7]}; }
#pragma unroll
        for (int i = 0; i < 2; ++i) { const int idx = tid + 512 * i, tok = idx & 63, c8 = (idx >> 6) * 8; const unsigned ww[4] = {vw[i].x, vw[i].y, vw[i].z, vw[i].w};
#pragma unroll
            for (int j = 0; j < 8; ++j) vT[(c8 + j) * 72 + tok] = (bf16_t)((j & 1) ? (ww[j >> 1] >> 16) : (ww[j >> 1] & 0xffffu)); }
        float kk[8];
#pragma unroll
        for (int i = 0; i < 8; ++i) kk[i] = bf2f(kn[i]);
        __syncthreads();
        const int un = u + gridDim.x; const bool more = un < 2048;
        if (more) GC_LOAD(un);
        float cl[8]; float run = 0.f;
#pragma unroll
        for (int i = 0; i < 8; ++i) { const LAS float* a = sA + (seg * 8 + i) * 16; float z = bgc;
#pragma unroll
            for (int r = 0; r < 16; ++r) z += a[r] * wr_[r];
            run += logsigmoid_f(z) * (1.0f / 16.0f); cl[i] = run; }
        sTot[seg * 64 + c] = run;
        __syncthreads();
        float pre = 0.f, tot = 0.f;
#pragma unroll
        for (int s = 0; s < 8; ++s) { const float v = sTot[s * 64 + c]; tot += v; if (s < seg) pre += v; }
        { float kd[8];
#pragma unroll
            for (int i = 0; i < 8; ++i) kd[i] = kk[i] * __expf(tot - (pre + cl[i]));
            *(LAS bf16x8*)(kdT + c * 72 + seg * 8) = pack8(kd); }
        if (seg == 0) AC[(size_t)u * 64 + c] = __expf(tot);
        __syncthreads();
        { bf16x8 bv[2];
#pragma unroll
            for (int ks = 0; ks < 2; ++ks) bv[ks] = *(const LAS bf16x8*)(vT + (wv * 16 + fr) * 72 + (ks * 4 + fq) * 8);
            bf16_t* ub = UB + (size_t)u * 8192 + (wv * 16 + fr) * 64 + fq * 4;
#pragma unroll
            for (int mt = 0; mt < 4; ++mt) { f32x4 acc = (f32x4){0.f, 0.f, 0.f, 0.f};
#pragma unroll
                for (int ks = 0; ks < 2; ++ks) { const bf16x8 av = *(const LAS bf16x8*)(kdT + (mt * 16 + fr) * 72 + (ks * 4 + fq) * 8);
                    acc = __builtin_amdgcn_mfma_f32_16x16x32_bf16(av, bv[ks], acc, 0, 0, 0); }
                u32x2 w; w.x = cvt_pk_bf16(acc[0], acc[1]); w.y = cvt_pk_bf16(acc[2], acc[3]); *(u32x2*)(ub + mt * 16) = w; } }
        if (!more) break;
        u = un;
    }
#undef GC_LOAD
    __syncthreads();
}
__device__ void phase_gla_scan(KP p, int wv) {
    asm volatile("" : "+s"(p));
    unsigned* UB = (unsigned*)(p->ws + WS_Y); const float* AC = (const float*)(p->ws + WS_AC);
    for (int e = blockIdx.x * 512 + otid(wv); e < 131072; e += gridDim.x * 512) {
        const int k2 = e & 31, v = (e >> 5) & 127, hd = (e >> 12) & 3, b = e >> 14;
        unsigned* ub = UB + (((size_t)b * 256 + hd) * 8192 + v * 64 + k2 * 2) / 2; const float* ab = AC + ((size_t)b * 256 + hd) * 64 + k2 * 2;
        float2 s = make_float2(0.f, 0.f);
        for (int n0 = 0; n0 < 64; n0 += 32) { unsigned uu[32]; float2 aa[32];
#pragma unroll
            for (int j = 0; j < 32; ++j) { uu[j] = ub[(size_t)(n0 + j) * 16384]; aa[j] = *(const float2*)(ab + (n0 + j) * 256); }
#pragma unroll
            for (int j = 0; j < 32; ++j) { s.x = aa[j].x * s.x + bf_lo(uu[j]); s.y = aa[j].y * s.y + bf_hi(uu[j]); ub[(size_t)(n0 + j) * 16384] = cvt_pk_bf16(s.x, s.y); } }
    }
}
__device__ void phase_gla_out(KP p, int l, LAS unsigned char* lds, int wv) {
    asm volatile("" : "+s"(p));
    LAS float* sO0 = (LAS float*)lds;
    const bf16_t* H = (const bf16_t*)(p->ws + WS_H); const bf16_t* UB = (const bf16_t*)(p->ws + WS_Y); bf16_t* MIX = (bf16_t*)(p->ws + WS_XN);
    const float* onorm = p->in[6] + (size_t)l * 512; const int tid = otid(wv), lane = tid & 63, fr = lane & 15, fq = lane >> 4;
    const int tt = tid >> 3, v0 = (tid & 7) * 16;
    int u = blockIdx.x; if (u >= 2048) return;
    bf16x8 bsn[2]; bf16x8 av[4][2]; u32x4 gw[2];
#define GO_LOAD(uu) do { const int hd_ = (uu) & 3, n_ = ((uu) >> 2) & 63, b_ = (uu) >> 8; const size_t t0_ = (size_t)b_ * SEQ + n_ * 64; \
        _Pragma("unroll") for (int ks = 0; ks < 2; ++ks) bsn[ks] = *(const bf16x8*)(UB + (size_t)(uu) * 8192 + (wv * 16 + fr) * 64 + ks * 32 + fq * 8); \
        _Pragma("unroll") for (int mt = 0; mt < 4; ++mt) _Pragma("unroll") for (int ks = 0; ks < 2; ++ks) av[mt][ks] = *(const bf16x8*)(H + (t0_ + mt * 16 + fr) * DINP + OFF_Q + hd_ * 64 + ks * 32 + fq * 8); \
        _Pragma("unroll") for (int h8 = 0; h8 < 2; ++h8) gw[h8] = *(const u32x4*)(H + (t0_ + tt) * DINP + OFF_G + hd_ * 128 + v0 + h8 * 8); } while (0)
    GO_LOAD(u);
    for (int it = 0;; ++it) {
        LAS float* sO = sO0 + (it & 1) * (64 * 132);
        const int hd = u & 3, n = (u >> 2) & 63, b = u >> 8; const size_t t0 = (size_t)b * SEQ + n * 64;
        const bf16x8 bs[2] = {bsn[0], bsn[1]};
#pragma unroll
        for (int mt = 0; mt < 4; ++mt) { f32x4 acc = (f32x4){0.f, 0.f, 0.f, 0.f};
#pragma unroll
            for (int ks = 0; ks < 2; ++ks) acc = __builtin_amdgcn_mfma_f32_16x16x32_bf16(av[mt][ks], bs[ks], acc, 0, 0, 0);
#pragma unroll
            for (int e = 0; e < 4; ++e) sO[(mt * 16 + fq * 4 + e) * 132 + wv * 16 + fr] = acc[e] * 0.125f; }
        float g[2][8]; unpack8(gw[0], g[0]); unpack8(gw[1], g[1]);
        __syncthreads();
        const int un = u + gridDim.x; const bool more = un < 2048;
        if (more) GO_LOAD(un);
        { f32x4 o[4]; float ss = 0.f;
#pragma unroll
            for (int q = 0; q < 4; ++q) { o[q] = *(const LAS f32x4*)(sO + tt * 132 + v0 + q * 4); ss += o[q][0] * o[q][0] + o[q][1] * o[q][1] + o[q][2] * o[q][2] + o[q][3] * o[q][3]; }
            ss = row8_sum(ss);
            const float rs = rsqrtf(ss * (1.0f / 128.0f) + EPS); bf16_t* op = MIX + (t0 + tt) * 1024 + hd * 128 + v0;
#pragma unroll
            for (int h8 = 0; h8 < 2; ++h8) { const float4 n0 = *(const float4*)(onorm + hd * 128 + v0 + h8 * 8), n1 = *(const float4*)(onorm + hd * 128 + v0 + h8 * 8 + 4);
                const f32x4 o0 = o[h8 * 2], o1 = o[h8 * 2 + 1];
                const float r[8] = {o0[0] * rs * n0.x * silu_f(g[h8][0]), o0[1] * rs * n0.y * silu_f(g[h8][1]), o0[2] * rs * n0.z * silu_f(g[h8][2]), o0[3] * rs * n0.w * silu_f(g[h8][3]),
                                    o1[0] * rs * n1.x * silu_f(g[h8][4]), o1[1] * rs * n1.y * silu_f(g[h8][5]), o1[2] * rs * n1.z * silu_f(g[h8][6]), o1[3] * rs * n1.w * silu_f(g[h8][7])};
                *(bf16x8*)(op + h8 * 8) = pack8(r); } }
        if (!more) break;
        u = un;
    }
#undef GO_LOAD
    __syncthreads();
}
__device__ void phase_sg(KP p, int l, LAS unsigned char* lds, int wv) {
    asm volatile("" : "+s"(p));
    LAS float* sStat = (LAS float*)lds; LAS bf16_t* svT0 = (LAS bf16_t*)(lds + 1024);
    const bf16_t* H = (const bf16_t*)(p->ws + WS_H); bf16_t* MIX = (bf16_t*)(p->ws + WS_XN); const bf16_t* WSB = (const bf16_t*)(p->ws + WS_AC + 524288) + (size_t)l * 4 * 128 * 128;
    const float* lng = p->in[7] + (size_t)l * 512; const float* lnb = p->in[8] + (size_t)l * 512; const float* bsp = p->in[10] + (size_t)l * 4 * 128;
    const int tid = otid(wv), lane = tid & 63, fr = lane & 15, fq = lane >> 4;
    for (int u = blockIdx.x; u < 256; u += gridDim.x) {
        const size_t t0 = (size_t)u * 128;
        for (int tb = 0; tb < 16; tb += 8) { u32x4 w8[8];
#pragma unroll
            for (int j = 0; j < 8; ++j) w8[j] = *(const u32x4*)(H + (t0 + wv * 16 + tb + j) * DINP + OFF_SV + lane * 8);
            float s1[8], s2[8];
#pragma unroll
            for (int j = 0; j < 8; ++j) { float f[8]; unpack8(w8[j], f); s1[j] = 0.f; s2[j] = 0.f;
#pragma unroll
                for (int e = 0; e < 8; ++e) { const float x = gelu_tanh(f[e]); s1[j] += x; s2[j] += x * x; } }
#pragma unroll
            for (int j = 0; j < 8; ++j) { s1[j] = wave_sum(s1[j], lane); s2[j] = wave_sum(s2[j], lane); }
            if (lane < 8) { float m1 = s1[0], m2 = s2[0];
#pragma unroll
                for (int j = 1; j < 8; ++j) if (lane == j) { m1 = s1[j]; m2 = s2[j]; }
                const float mu = m1 * (1.0f / 512.0f), var = fmaxf(m2 * (1.0f / 512.0f) - mu * mu, 0.f);
                sStat[(wv * 16 + tb + lane) * 2] = mu; sStat[(wv * 16 + tb + lane) * 2 + 1] = rsqrtf(var + EPS); } }
        __syncthreads();
        u32x4 svw[4];
#pragma unroll
        for (int it = 0; it < 4; ++it) { const int idx = tid + 512 * it, j = idx & 127, c8 = (idx >> 7) * 8; svw[it] = *(const u32x4*)(H + (t0 + j) * DINP + OFF_SV + c8); }
        for (int g = 0; g < 4; ++g) {
            LAS bf16_t* svT = svT0 + (g & 1) * (128 * 136);
            const int i = wv * 16 + fr; const size_t tok = t0 + i;
            bf16x8 wb[4]; u32x2 uw[8];
#pragma unroll
            for (int ks = 0; ks < 4; ++ks) wb[ks] = *(const bf16x8*)(WSB + ((size_t)g * 128 + i) * 128 + ks * 32 + fq * 8);
#pragma unroll
            for (int mt = 0; mt < 8; ++mt) uw[mt] = *(const u32x2*)(H + tok * DINP + OFF_U + g * 128 + mt * 16 + fq * 4);
            const float bs = bsp[g * 128 + i];
#pragma unroll
            for (int it = 0; it < 4; ++it) { const int idx = tid + 512 * it, j = idx & 127, c8 = (idx >> 7) * 8; float f[8];
                unpack8(svw[it], f);
                const float mu = sStat[j * 2], rs = sStat[j * 2 + 1];
#pragma unroll
                for (int e = 0; e < 8; ++e) { const float o = (gelu_tanh(f[e]) - mu) * rs * lng[g * 128 + c8 + e] + lnb[g * 128 + c8 + e];
                    svT[(c8 + e) * 136 + j] = (bf16_t)(cvt_pk_bf16(o, 0.f) & 0xffffu); } }
            __syncthreads();
            if (g < 3) {
#pragma unroll
                for (int it = 0; it < 4; ++it) { const int idx = tid + 512 * it, j = idx & 127, c8 = (idx >> 7) * 8; svw[it] = *(const u32x4*)(H + (t0 + j) * DINP + OFF_SV + (g + 1) * 128 + c8); } }
            f32x4 acc[8];
#pragma unroll
            for (int mt = 0; mt < 8; ++mt) { acc[mt] = (f32x4){0.f, 0.f, 0.f, 0.f};
#pragma unroll
                for (int ks = 0; ks < 4; ++ks) if (ks < 2 || wv >= 4) {
                    const bf16x8 av = *(const LAS bf16x8*)(svT + (mt * 16 + fr) * 136 + ks * 32 + fq * 8);
                    acc[mt] = __builtin_amdgcn_mfma_f32_16x16x32_bf16(av, wb[ks], acc[mt], 0, 0, 0); } }
#pragma unroll
            for (int mt = 0; mt < 8; ++mt) { const int cc = g * 128 + mt * 16 + fq * 4;
                const float r0 = gelu_tanh(bf_lo(uw[mt].x)) * (acc[mt][0] + bs), r1 = gelu_tanh(bf_hi(uw[mt].x)) * (acc[mt][1] + bs);
                const float r2 = gelu_tanh(bf_lo(uw[mt].y)) * (acc[mt][2] + bs), r3 = gelu_tanh(bf_hi(uw[mt].y)) * (acc[mt][3] + bs);
                u32x2 w; w.x = cvt_pk_bf16(r0, r1); w.y = cvt_pk_bf16(r2, r3);
                *(u32x2*)(MIX + tok * 1024 + 512 + cc) = w; }
        }
        __syncthreads();
    }
}
__device__ void phase_convert_wsp(KP p, int wv) {
    asm volatile("" : "+s"(p));
    const float4* src = (const float4*)p->in[9]; u32x2* dst = (u32x2*)(p->ws + WS_AC + 524288);
    for (int i = blockIdx.x * 512 + otid(wv); i < DEPTH * 4 * 128 * 128 / 4; i += gridDim.x * 512) { const float4 v = src[i]; u32x2 w; w.x = cvt_pk_bf16(v.x, v.y); w.y = cvt_pk_bf16(v.z, v.w); dst[i] = w; }
}

#define XB_TMO      128
#define XB_XCNT(j)  (256  + 64 * (j))
#define XB_XSUB(j)  (1280 + 64 * (j))
#define XB_XGEN(j)  (2304 + 64 * (j))
#define XB_TOP      3328
#define XB_TOPGEN   3392
#define XCD_BAR_WORDS 3456
#define XB_SPIN_CAP (1u << 22)
__device__ __forceinline__ unsigned xb_ld(unsigned* p)              { return __hip_atomic_load(p, __ATOMIC_RELAXED, __HIP_MEMORY_SCOPE_AGENT); }
__device__ __forceinline__ unsigned xb_add(unsigned* p, unsigned v) { return __hip_atomic_fetch_add(p, v, __ATOMIC_RELAXED, __HIP_MEMORY_SCOPE_AGENT); }
__device__ __forceinline__ unsigned xb_xcc_id() { return (unsigned)__builtin_amdgcn_s_getreg((3 << 11) | 20) & 0xFu; }
#define XB_SPIN(cond, bar) do { unsigned _sp = 0; while (cond) { __builtin_amdgcn_s_sleep(1); \
    if ((++_sp & 255u) == 0u) { if (xb_ld(&(bar)[XB_TMO])) break; if (_sp > XB_SPIN_CAP) { atomicAdd(&(bar)[XB_TMO], 1u); break; } } } } while (0)
struct XcdBarrier { unsigned* bar; unsigned x; volatile LAS unsigned* st; };
__device__ __forceinline__ XcdBarrier xcd_barrier_post(unsigned* bar, volatile LAS unsigned* st) {
    XcdBarrier b; b.bar = bar; b.x = xb_xcc_id(); b.st = st;
    if (threadIdx.x == 0) (void)xb_add(&bar[XB_XCNT(b.x)], 1u);
    return b;
}
__device__ __forceinline__ void xcd_barrier_complete(unsigned* bar, unsigned x, unsigned& nloc, unsigned& nx) {
    const unsigned G = gridDim.x * gridDim.y * gridDim.z;
    unsigned sum, cnt, mine, sp = 0u;
    for (;;) {
        sum = 0u; cnt = 0u; mine = 0u;
#pragma unroll
        for (unsigned j = 0; j < 16; ++j) { const unsigned c = xb_ld(&bar[XB_XCNT(j)]); sum += c; cnt += (c > 0u) ? 1u : 0u; mine = (j == x) ? c : mine; }
        if (sum == G) break;
        __builtin_amdgcn_s_sleep(1);
        if ((++sp & 255u) == 0u) { if (xb_ld(&bar[XB_TMO])) break; if (sp > XB_SPIN_CAP) { atomicAdd(&bar[XB_TMO], 1u); break; } }
    }
    nloc = mine > 0u ? mine : 1u; nx = cnt > 0u ? cnt : 1u;
}
__device__ __forceinline__ void xcd_barrier(const XcdBarrier& b, const int tid) {
    asm volatile("s_waitcnt vmcnt(0)" ::: "memory");
    __syncthreads();
    if (tid == 0) {
        unsigned* bar = b.bar;
        __builtin_amdgcn_s_waitcnt(0);
        unsigned nloc = b.st[0], nx = b.st[1];
        if (nloc == 0u) { xcd_barrier_complete(bar, b.x, nloc, nx); b.st[0] = nloc; b.st[1] = nx; }
        const unsigned old = xb_add(&bar[XB_XSUB(b.x)], 1u);
        const unsigned gen = old / nloc;
        if (old + 1u == (gen + 1u) * nloc) {
            __builtin_amdgcn_fence(__ATOMIC_RELEASE, "agent");
            asm volatile("s_waitcnt vmcnt(0)" ::: "memory");
            const unsigned og = xb_add(&bar[XB_TOP], 1u);
            const unsigned tg = og / nx;
            __builtin_amdgcn_fence(__ATOMIC_ACQUIRE, "agent");
            if (og + 1u == (tg + 1u) * nx) xb_add(&bar[XB_TOPGEN], 1u);
            else XB_SPIN(xb_ld(&bar[XB_TOPGEN]) == tg, bar);
            asm volatile("s_waitcnt vmcnt(0)" ::: "memory");
        } else {
            __builtin_amdgcn_fence(__ATOMIC_ACQUIRE, "agent");
            XB_SPIN(xb_ld(&bar[XB_TOPGEN]) == gen, bar);
            asm volatile("s_waitcnt vmcnt(0)" ::: "memory");
        }
    }
    __syncthreads();
}

__global__ void __launch_bounds__(512) fwd_megakernel(Params p_unused) {
    KP p = (KP)__builtin_amdgcn_kernarg_segment_ptr();
    extern __shared__ __attribute__((aligned(16))) unsigned char shm[];
    cg::grid_group grid = cg::this_grid();
    LAS unsigned char* lds = (LAS unsigned char*)shm; float* smf = (float*)shm;
    const int G = gridDim.x, c = blockIdx.x;
    volatile LAS unsigned* xbw = (volatile LAS unsigned*)(lds + LDS_MAIN);
    if (threadIdx.x < 4) xbw[threadIdx.x] = 0u;
    __syncthreads();
    const XcdBarrier xbar = xcd_barrier_post((unsigned*)(fresh(p)->ws + WS_BAR), xbw);
const int wv = __builtin_amdgcn_readfirstlane(threadIdx.x >> 6);
#define GSYNC() do { xcd_barrier(xbar, otid(wv)); if (PROBE & 16) xcd_barrier(xbar, otid(wv)); } while (0)
    bf16_t* W = (bf16_t*)(fresh(p)->ws + WS_W); bf16_t* KB = (bf16_t*)(fresh(p)->ws + WS_K); bf16_t* VT = (bf16_t*)(fresh(p)->ws + WS_VT);
    bf16_t* XN = (bf16_t*)(fresh(p)->ws + WS_XN); bf16_t* Hb = (bf16_t*)(fresh(p)->ws + WS_H); bf16_t* Yb = (bf16_t*)(fresh(p)->ws + WS_Y);
    bf16_t* MEMN = (bf16_t*)(fresh(p)->ws + WS_MEMN);
    float* RS = (float*)(fresh(p)->ws + WS_BAR + 65536);

    for (int rep = 0; rep < ((PROBE & 4) ? 2 : 1); ++rep) phase_convert_weights(fresh(p), smf, wv);
    phase_convert_wsp(fresh(p), wv);
    phase_x_init(fresh(p)->in[0], (bf16_t*)fresh(p)->out, RS, wv);
    for (int l = 0; l < DEPTH; ++l) rms_rows_bf16(fresh(p)->in[1], fresh(p)->in[14] + (size_t)l * 1024, MEMN + (size_t)l * 2048 * 1024, BATCH * NMEM, wv);
    GSYNC();
    if (fresh(p)->ws == nullptr) grid.sync();

    for (int l = 0; l < DEPTH; ++l) {
        const bf16_t* wl = W + (size_t)l * WL_SZ;
        for (int rep = 0; rep < ((PROBE & 1) ? 2 : 1); ++rep) { pg8::SchedInKV S{(const bf16_t*)fresh(p)->out, wl + WIN_O, MEMN + (size_t)l * 2048 * 1024, wl + WXKV_O, l, G, c}; pg8::EpiBf16 E{(bf16_t*)fresh(p)->ws, RS}; pg8::gemm_phase<1024, 1024, 1024>(lds, S, E, wv); }
        GSYNC();
        for (int rep = 0; rep < ((PROBE & 2) ? 2 : 1); ++rep) phase_gla_chunk(fresh(p), l, lds, wv);
        GSYNC();
        for (int step = 0; step < 2; ++step) { if ((step ^ ((c >> 3) & 1)) == 0) phase_gla_scan(fresh(p), wv); else phase_sg(fresh(p), l, lds, wv); }
        GSYNC();
        for (int rep = 0; rep < ((PROBE & 2) ? 2 : 1); ++rep) phase_gla_out(fresh(p), l, lds, wv);
        GSYNC();
        for (int rep = 0; rep < ((PROBE & 1) ? 2 : 1); ++rep) { pg8::SchedStd<0> S{XN, wl + WOUT_O, 128, 4, 1024, 1024, 1024, G, c}; pg8::EpiBf16 E{Yb}; pg8::gemm_phase<1024, 1024, 1024>(lds, S, E, wv); }
        GSYNC();
        phase_norm_res<true, true>(Yb, fresh(p)->out, fresh(p)->out, fresh(p)->in[12] + (size_t)l * 1024, RS, wv);
        GSYNC();
        #define LOCAL_SEAM() do { asm volatile("s_waitcnt vmcnt(0)" ::: "memory"); __syncthreads(); } while (0)
        for (int rep = 0; rep < ((PROBE & 1) ? 2 : 1); ++rep) { pg8::SchedAttn<2> S{(const bf16_t*)fresh(p)->out, wl + WXQ_O, G, c}; pg8::EpiBf16 E{Yb, RS}; pg8::gemm_phase<1024, 1024, 1024>(lds, S, E, wv); }
        LOCAL_SEAM();
        for (int rep = 0; rep < ((PROBE & 1) ? 2 : 1); ++rep) { pg8::SchedAttn<0> S{Yb, KB + (size_t)l * 2048 * 1024, G, c}; pg8::EpiSoftmax E{Hb, 0.0625f * 1.4426950408889634f, (LAS float*)(lds + pg8::STAGE_BYTES)}; pg8::gemm_phase<1024, 1024, 256>(lds, S, E, wv); }
        LOCAL_SEAM();
        for (int rep = 0; rep < ((PROBE & 1) ? 2 : 1); ++rep) { pg8::SchedAttn<1> S{Hb, VT + (size_t)l * 8 * 1024 * 256, G, c}; pg8::EpiBf16 E{Yb}; pg8::gemm_phase<1024, 256, 256>(lds, S, E, wv); }
        GSYNC();
        for (int rep = 0; rep < ((PROBE & 1) ? 2 : 1); ++rep) { pg8::SchedStd<0> S{Yb, wl + WXO_O, 128, 4, 1024, 1024, 1024, G, c}; pg8::EpiBf16 E{Hb}; pg8::gemm_phase<1024, 1024, 1024>(lds, S, E, wv); }
        GSYNC();
        phase_norm_res<true, true>(Hb, fresh(p)->out, l + 1 < DEPTH ? (void*)fresh(p)->out : (void*)W, fresh(p)->in[18] + (size_t)l * 1024, RS, wv);
        GSYNC();
        for (int rep = 0; rep < ((PROBE & 1) ? 2 : 1); ++rep) { pg8::SchedStd<1> S{l + 1 < DEPTH ? (const bf16_t*)fresh(p)->out : (const bf16_t*)W, wl + WGU_O, 128, 22, 1024, 1024, DFF, G, c}; pg8::EpiSwiglu E{Hb, RS}; pg8::gemm_phase<1024, 1024, 1024>(lds, S, E, wv); }
        GSYNC();
        for (int rep = 0; rep < ((PROBE & 1) ? 2 : 1); ++rep) { pg8::SchedStd<0> S{Hb, wl + WDN_O, 128, 4, DFF, DFF, 1024, G, c}; pg8::EpiBf16 E{Yb}; pg8::gemm_phase<DFF, DFF, DFF>(lds, S, E, wv); }
        GSYNC();
        if (l + 1 < DEPTH) phase_norm_res<true, true>(Yb, fresh(p)->out, fresh(p)->out, fresh(p)->in[22] + (size_t)l * 1024, RS, wv);
        else phase_norm_res<true, false>(Yb, (const void*)W, fresh(p)->out, fresh(p)->in[22] + (size_t)l * 1024, nullptr, wv);
        if (l + 1 < DEPTH) GSYNC();
    }
}

extern "C" void kernel_launch(void* const* d_in, const int* in_sizes, int n_in, void* d_out, int out_size, void* d_ws, size_t ws_size, hipStream_t stream) {
    static int grid_blocks = 0;
    if (grid_blocks == 0) {
        if (n_in != 23 || ws_size < WS_END) { fprintf(stderr, "kernel_launch: unexpected n_in %d / ws_size %zu\n", n_in, ws_size); grid_blocks = -1; return; }
        int dev = 0, cus = 0, per_cu = 0;
        hipGetDevice(&dev);
        hipDeviceGetAttribute(&cus, hipDeviceAttributeMultiprocessorCount, dev);
        if (hipFuncSetAttribute((const void*)fwd_megakernel, hipFuncAttributeMaxDynamicSharedMemorySize, LDS_BYTES) != hipSuccess) { fprintf(stderr, "kernel_launch: hipFuncSetAttribute failed\n"); grid_blocks = -1; return; }
        if (hipOccupancyMaxActiveBlocksPerMultiprocessor(&per_cu, (const void*)fwd_megakernel, 512, LDS_BYTES) != hipSuccess || per_cu < 1) { fprintf(stderr, "kernel_launch: occupancy query failed (%d)\n", per_cu); (void)hipGetLastError(); per_cu = 1; }
        grid_blocks = cus * 1;
        fprintf(stderr, "kernel_launch: cus %d per_cu %d grid %d\n", cus, per_cu, grid_blocks);
    }
    if (grid_blocks < 0) return;
    if (hipMemsetAsync((char*)d_ws + WS_BAR, 0, XCD_BAR_WORDS * 4, stream) != hipSuccess) { fprintf(stderr, "kernel_launch: memset of barrier words failed\n"); return; }
    Params p{};
    for (int i = 0; i < 23; ++i) p.in[i] = (const float*)d_in[i];
    p.out = (float*)d_out; p.ws = (unsigned char*)d_ws;
    void* args[] = {&p};
    hipError_t e = hipLaunchCooperativeKernel((const void*)fwd_megakernel, dim3(grid_blocks), dim3(512), args, LDS_BYTES, stream);
    if (e != hipSuccess) fprintf(stderr, "cooperative launch failed: %s (grid %d)\n", hipGetErrorString(e), grid_blocks);
}
```
